# Optimizing an MI355X kernel written in HIP

```python
import jax, jax.numpy as jnp
from jax import lax
import numpy as np

D_MODEL = 1024
BATCH = 8
SEQ = 2048
DEPTH = 4

HEAD_DIM = 64
GRID_W = 64
MEM_LEN = 256
Q_BLOCK = 128
ROPE_THETA = 10000.0
EPS = 1e-6
NEG = -1e30

A_HEADS = 8
A_KV_HEADS = 2
B_HEADS = 8
B_KV_HEADS = 2
B_WINDOW = 128
C_HEADS = 8
C_Q_RANK = 256
C_KV_RANK = 128
C_NOPE = 64
C_ROPE = 32
C_V = 64
D_HEADS = 8
D_WIN_R = 8
D_WIN_C = 16
X_HEADS = 4
X_HEAD_DIM = 128
D_FF = -(-8 * D_MODEL // (3 * 256)) * 256

AB_SIZES = (A_HEADS * HEAD_DIM, A_KV_HEADS * HEAD_DIM, A_KV_HEADS * HEAD_DIM,
            B_HEADS * HEAD_DIM, B_KV_HEADS * HEAD_DIM, B_KV_HEADS * HEAD_DIM)
CD_SIZES = (C_Q_RANK, C_KV_RANK, C_ROPE,
            D_HEADS * HEAD_DIM, D_HEADS * HEAD_DIM, D_HEADS * HEAD_DIM)
IN_AB = sum(AB_SIZES)
IN_CD = sum(CD_SIZES)
MIX_AB = (A_HEADS + B_HEADS) * HEAD_DIM
MIX_CD = C_HEADS * C_V + D_HEADS * HEAD_DIM

kernel_name = "hybrid_gqa_swa_mla_natten_encoder"


def _split(z, sizes):
    idx = [int(v) for v in np.cumsum(sizes)[:-1]]
    return jnp.split(z, idx, axis=-1)


def rms_norm(x, g):
    xf = x.astype(jnp.float32)
    y = xf * lax.rsqrt(jnp.mean(xf * xf, axis=-1, keepdims=True) + EPS)
    return (y * g.astype(jnp.float32)).astype(x.dtype)


def rope_angles(pos, dim):
    inv = ROPE_THETA ** (-jnp.arange(0, dim, 2, dtype=jnp.float32) / dim)
    return pos.astype(jnp.float32)[:, None] * inv[None, :]


def apply_rope(x, ang):
    cos = jnp.cos(ang)[None, :, None, :]
    sin = jnp.sin(ang)[None, :, None, :]
    x1, x2 = jnp.split(x.astype(jnp.float32), 2, axis=-1)
    out = jnp.concatenate([x1 * cos - x2 * sin, x1 * sin + x2 * cos], axis=-1)
    return out.astype(x.dtype)


def blocked_dense_attention(q, k, v, scale):
    B, S = q.shape[0], q.shape[1]
    nb = S // Q_BLOCK
    qb = q.reshape(B, nb, Q_BLOCK, *q.shape[2:]).swapaxes(0, 1)

    def one_block(q_blk):
        s = jnp.einsum('bqhgd,bkhd->bhgqk', q_blk, k,
                       preferred_element_type=jnp.float32) * scale
        p = jax.nn.softmax(s, axis=-1).astype(v.dtype)
        return jnp.einsum('bhgqk,bkhd->bqhgd', p, v)

    out = lax.map(one_block, qb)
    return out.swapaxes(0, 1).reshape(B, S, -1)


def window_attention_with_sink(q, k, v, sink, scale):
    B, S, Hkv, G, d = q.shape
    nb = S // Q_BLOCK
    pad = ((0, 0), (Q_BLOCK, Q_BLOCK), (0, 0), (0, 0))
    kp = jnp.pad(k, pad).reshape(B, nb + 2, Q_BLOCK, Hkv, d)
    vp = jnp.pad(v, pad).reshape(B, nb + 2, Q_BLOCK, Hkv, d)
    kb = jnp.concatenate([kp[:, :-2], kp[:, 1:-1], kp[:, 2:]], axis=2)
    vb = jnp.concatenate([vp[:, :-2], vp[:, 1:-1], vp[:, 2:]], axis=2)
    qb = q.reshape(B, nb, Q_BLOCK, Hkv, G, d)
    s = jnp.einsum('bnqhgd,bnkhd->bnhgqk', qb, kb,
                   preferred_element_type=jnp.float32) * scale
    blk = jnp.arange(nb)[:, None, None] * Q_BLOCK
    q_abs = blk + jnp.arange(Q_BLOCK)[None, :, None]
    k_abs = blk - Q_BLOCK + jnp.arange(3 * Q_BLOCK)[None, None, :]
    valid = (jnp.abs(k_abs - q_abs) <= B_WINDOW) & (k_abs >= 0) & (k_abs < S)
    s = jnp.where(valid[None, :, None, None], s, NEG)
    sink_col = jnp.broadcast_to(sink.astype(jnp.float32).reshape(1, 1, Hkv, G, 1, 1),
                                s.shape[:-1] + (1,))
    p = jax.nn.softmax(jnp.concatenate([s, sink_col], axis=-1), axis=-1)[..., :-1]
    out = jnp.einsum('bnhgqk,bnkhd->bnqhgd', p.astype(v.dtype), vb)
    return out.reshape(B, S, Hkv * G * d)


def neighbourhood_attention(q, k, v, rpb, scale):
    B, S, H, d = q.shape
    rows = S // GRID_W
    wr = min(D_WIN_R, rows)
    c = jnp.arange(GRID_W)
    c0 = jnp.clip(c - D_WIN_C // 2, 0, GRID_W - D_WIN_C)
    col_valid = (c[None, :] >= c0[:, None]) & (c[None, :] < c0[:, None] + D_WIN_C)
    valid = jnp.tile(col_valid, (1, wr))
    col_idx = jnp.clip(c[None, :] - c[:, None] + (D_WIN_C - 1), 0, 2 * D_WIN_C - 2)
    qg = q.reshape(B, rows, GRID_W, H, d)
    kg = k.reshape(B, rows, GRID_W, H, d)
    vg = v.reshape(B, rows, GRID_W, H, d)
    rpb_f = rpb.astype(jnp.float32)

    def one_row(args):
        q_row, r = args
        r0 = jnp.clip(r - wr // 2, 0, rows - wr)
        k_win = lax.dynamic_slice_in_dim(kg, r0, wr, axis=1).reshape(B, wr * GRID_W, H, d)
        v_win = lax.dynamic_slice_in_dim(vg, r0, wr, axis=1).reshape(B, wr * GRID_W, H, d)
        s = jnp.einsum('bqhd,bkhd->bhqk', q_row, k_win,
                       preferred_element_type=jnp.float32) * scale
        row_idx = r0 + jnp.arange(wr) - r + (D_WIN_R - 1)
        bias = rpb_f[:, row_idx[None, :, None], col_idx[:, None, :]]
        s = jnp.where(valid, s + bias.reshape(H, GRID_W, wr * GRID_W)[None], NEG)
        p = jax.nn.softmax(s, axis=-1).astype(v.dtype)
        return jnp.einsum('bhqk,bkhd->bqhd', p, v_win)

    out = lax.map(one_row, (qg.swapaxes(0, 1), jnp.arange(rows)))
    return out.swapaxes(0, 1).reshape(B, S, H * d)


def mixer_ab(h, w_in, g_qa, g_ka, sink, w_out, ang_1d, ang_2d):
    B, S, _ = h.shape
    qa, ka, va, qb, kb, vb = _split(h @ w_in, AB_SIZES)
    qa = apply_rope(rms_norm(qa.reshape(B, S, A_HEADS, HEAD_DIM), g_qa), ang_2d)
    ka = apply_rope(rms_norm(ka.reshape(B, S, A_KV_HEADS, HEAD_DIM), g_ka), ang_2d)
    qa = qa.reshape(B, S, A_KV_HEADS, A_HEADS // A_KV_HEADS, HEAD_DIM)
    va = va.reshape(B, S, A_KV_HEADS, HEAD_DIM)
    oa = blocked_dense_attention(qa, ka, va, HEAD_DIM ** -0.5)
    qb = apply_rope(qb.reshape(B, S, B_HEADS, HEAD_DIM), ang_1d)
    kb = apply_rope(kb.reshape(B, S, B_KV_HEADS, HEAD_DIM), ang_1d)
    qb = qb.reshape(B, S, B_KV_HEADS, B_HEADS // B_KV_HEADS, HEAD_DIM)
    vb = vb.reshape(B, S, B_KV_HEADS, HEAD_DIM)
    ob = window_attention_with_sink(qb, kb, vb, sink, HEAD_DIM ** -0.5)
    return jnp.concatenate([oa, ob], axis=-1) @ w_out


def mixer_cd(h, w_in, g_cq, g_ckv, w_uq, w_ukv, rpb, w_out, ang_c):
    B, S, _ = h.shape
    cq, ckv, kr, qd, kd, vd = _split(h @ w_in, CD_SIZES)
    q = (rms_norm(cq, g_cq) @ w_uq).reshape(B, S, C_HEADS, C_NOPE + C_ROPE)
    q_nope, q_rope = jnp.split(q, [C_NOPE], axis=-1)
    q_rope = apply_rope(q_rope, ang_c)
    kv = (rms_norm(ckv, g_ckv) @ w_ukv).reshape(B, S, C_HEADS, C_NOPE + C_V)
    k_nope, v_c = jnp.split(kv, [C_NOPE], axis=-1)
    k_rope = apply_rope(kr.reshape(B, S, 1, C_ROPE), ang_c)
    qc = jnp.concatenate([q_nope, q_rope], axis=-1)[:, :, :, None, :]
    kc = jnp.concatenate([k_nope, jnp.broadcast_to(k_rope, (B, S, C_HEADS, C_ROPE))], axis=-1)
    oc = blocked_dense_attention(qc, kc, v_c, (C_NOPE + C_ROPE) ** -0.5)
    od = neighbourhood_attention(qd.reshape(B, S, D_HEADS, HEAD_DIM),
                                 kd.reshape(B, S, D_HEADS, HEAD_DIM),
                                 vd.reshape(B, S, D_HEADS, HEAD_DIM), rpb, HEAD_DIM ** -0.5)
    return jnp.concatenate([oc, od], axis=-1) @ w_out


def memory_cross_attention(h, m, w_q, w_kv, w_o):
    B, S, _ = h.shape
    q = (h @ w_q).reshape(B, S, X_HEADS, X_HEAD_DIM)
    k, v = jnp.split(m @ w_kv, 2, axis=-1)
    k = k.reshape(B, m.shape[1], X_HEADS, X_HEAD_DIM)
    v = v.reshape(B, m.shape[1], X_HEADS, X_HEAD_DIM)
    s = jnp.einsum('bqhd,bkhd->bhqk', q, k, preferred_element_type=jnp.float32) * X_HEAD_DIM ** -0.5
    p = jax.nn.softmax(s, axis=-1).astype(v.dtype)
    o = jnp.einsum('bhqk,bkhd->bqhd', p, v).reshape(B, S, X_HEADS * X_HEAD_DIM)
    return o @ w_o


def swiglu(h, w_gate_up, w_down):
    g, u = jnp.split(h @ w_gate_up, 2, axis=-1)
    return (jax.nn.silu(g) * u) @ w_down


def setup_inputs(seed: int = 0) -> dict:
    key = jax.random.key(seed)
    ks = jax.random.split(key, 24)
    n_even = (DEPTH + 1) // 2
    n_odd = DEPTH // 2

    def w(k, shape, fan_in):
        return jax.random.normal(k, shape, jnp.float32) * fan_in ** -0.5

    def gain(k, shape):
        return 1.0 + 0.05 * jax.random.normal(k, shape, jnp.float32)

    return {
        'x': jax.random.normal(ks[0], (BATCH, SEQ, D_MODEL), jnp.float32),
        'mem': jax.random.normal(ks[1], (BATCH, MEM_LEN, D_MODEL), jnp.float32),
        'g_mix': gain(ks[2], (DEPTH, D_MODEL)),
        'w_in_ab': w(ks[3], (n_even, D_MODEL, IN_AB), D_MODEL),
        'g_qa': gain(ks[4], (n_even, HEAD_DIM)),
        'g_ka': gain(ks[5], (n_even, HEAD_DIM)),
        'sink_b': jax.random.normal(ks[6], (n_even, B_HEADS), jnp.float32),
        'w_out_ab': w(ks[7], (n_even, MIX_AB, D_MODEL), MIX_AB),
        'w_in_cd': w(ks[8], (n_odd, D_MODEL, IN_CD), D_MODEL),
        'g_cq': gain(ks[9], (n_odd, C_Q_RANK)),
        'g_ckv': gain(ks[10], (n_odd, C_KV_RANK)),
        'w_uq': w(ks[11], (n_odd, C_Q_RANK, C_HEADS * (C_NOPE + C_ROPE)), C_Q_RANK),
        'w_ukv': w(ks[12], (n_odd, C_KV_RANK, C_HEADS * (C_NOPE + C_V)), C_KV_RANK),
        'rpb_d': 0.1 * jax.random.normal(ks[13], (n_odd, D_HEADS, 2 * D_WIN_R - 1, 2 * D_WIN_C - 1), jnp.float32),
        'w_out_cd': w(ks[14], (n_odd, MIX_CD, D_MODEL), MIX_CD),
        'g_xq': gain(ks[15], (DEPTH, D_MODEL)),
        'g_mem': gain(ks[16], (DEPTH, D_MODEL)),
        'w_xq': w(ks[17], (DEPTH, D_MODEL, X_HEADS * X_HEAD_DIM), D_MODEL),
        'w_xkv': w(ks[18], (DEPTH, D_MODEL, 2 * X_HEADS * X_HEAD_DIM), D_MODEL),
        'w_xo': w(ks[19], (DEPTH, X_HEADS * X_HEAD_DIM, D_MODEL), X_HEADS * X_HEAD_DIM),
        'g_ffn': gain(ks[20], (DEPTH, D_MODEL)),
        'w_gate_up': w(ks[21], (DEPTH, D_MODEL, 2 * D_FF), D_MODEL),
        'w_down': w(ks[22], (DEPTH, D_FF, D_MODEL), D_FF),
        'g_final': gain(ks[23], (D_MODEL,)),
    }


def reference(x, mem, g_mix, w_in_ab, g_qa, g_ka, sink_b, w_out_ab, w_in_cd, g_cq, g_ckv,
              w_uq, w_ukv, rpb_d, w_out_cd, g_xq, g_mem, w_xq, w_xkv, w_xo, g_ffn,
              w_gate_up, w_down, g_final):
    S = x.shape[1]
    pos = jnp.arange(S)
    row = pos // GRID_W
    col = pos % GRID_W
    ang_1d = rope_angles(pos, HEAD_DIM)
    ang_2d = jnp.concatenate([rope_angles(row, HEAD_DIM // 2),
                              rope_angles(col, HEAD_DIM // 2)], axis=-1)
    ang_c = rope_angles(pos, C_ROPE)
    for i in range(DEPTH):
        j = i // 2
        h = rms_norm(x, g_mix[i])
        if i % 2 == 0:
            x = x + mixer_ab(h, w_in_ab[j], g_qa[j], g_ka[j], sink_b[j], w_out_ab[j],
                             ang_1d, ang_2d)
        else:
            x = x + mixer_cd(h, w_in_cd[j], g_cq[j], g_ckv[j], w_uq[j], w_ukv[j],
                             rpb_d[j], w_out_cd[j], ang_c)
        x = x + memory_cross_attention(rms_norm(x, g_xq[i]), rms_norm(mem, g_mem[i]),
                                       w_xq[i], w_xkv[i], w_xo[i])
        x = x + swiglu(rms_norm(x, g_ffn[i]), w_gate_up[i], w_down[i])
    return rms_norm(x, g_final)
```

```cpp
#include <hip/hip_runtime.h>
#include <hip/hip_cooperative_groups.h>
#include <cstdio>
namespace cg = cooperative_groups;

typedef unsigned short bf16_t;
typedef short bf16x8 __attribute__((ext_vector_type(8)));
typedef short s16x4 __attribute__((ext_vector_type(4)));
typedef float f32x16 __attribute__((ext_vector_type(16)));
typedef float f32x4 __attribute__((ext_vector_type(4)));
typedef float f32x2 __attribute__((ext_vector_type(2)));
typedef __bf16 bf2_t __attribute__((ext_vector_type(2)));
typedef unsigned u32x4 __attribute__((ext_vector_type(4)));
typedef unsigned u32x2 __attribute__((ext_vector_type(2)));

#define DI __device__ __forceinline__
#define MFMA32(a, b, c) __builtin_amdgcn_mfma_f32_32x32x16_bf16((a), (b), (c), 0, 0, 0)

constexpr int NTOK = 16384;
constexpr int SEQ = 2048;
constexpr int DM = 1024;
constexpr int ZLD = 2048;
constexpr float EPS = 1e-6f;
constexpr float LOG2E = 1.4426950408889634f;
constexpr int NT = 512;
constexpr int SMEM_MAIN = 135168;
constexpr int SMEM_RSTD = SMEM_MAIN + 16;
constexpr int SMEM_BYTES = SMEM_MAIN + 16 + 1024;
#ifndef REP_SYNC
#define REP_SYNC 1
#endif
#define GSYNC() do { for (int _r = 0; _r < REP_SYNC; ++_r) xcd_barrier(xbar); } while (0)
#ifndef REP_P1
#define REP_P1 1
#endif
#ifndef REP_P4
#define REP_P4 1
#endif
#ifndef REP_P7
#define REP_P7 1
#endif
#ifndef REP_P2
#define REP_P2 1
#endif

constexpr size_t OFF_XB = 0;
constexpr size_t OFF_Z = 33554432;
constexpr size_t OFF_O = 100663296;
constexpr size_t OFF_QC = 134217728;
constexpr size_t OFF_KVC = 159383552;
constexpr size_t OFF_MEMB = 192937984;
constexpr size_t OFF_MEMKV = 197132288;
constexpr size_t OFF_W = 201326592;
constexpr size_t OFF_SS = 258211840;
constexpr size_t OFF_SSMEM = 259260416;
constexpr size_t OFF_SSCQ = 259268608;
constexpr size_t OFF_SSCKV = 259530752;
constexpr size_t OFF_CS1 = 259661824;
constexpr size_t OFF_CS2 = 260186112;
constexpr size_t OFF_CSC = 260710400;
constexpr size_t OFF_BAR = 260972544;
constexpr size_t W_IN = 0, W_UQ = 2097152, W_UKV = 2293760, W_OUT = 2424832, W_XQ = 3473408, W_XKV = 3997696,
                 W_XO = 5046272, W_GU = 5570560, W_DOWN = 11337728, WSZ = 14221312;

struct Params {
  const float* in[24];
  float* out;
  unsigned char* ws;
};

__shared__ __attribute__((aligned(16))) unsigned char smem[SMEM_BYTES];

DI unsigned pack2(float a, float b) {
  f32x2 v = {a, b};
  bf2_t r = __builtin_convertvector(v, bf2_t);
  return __builtin_bit_cast(unsigned, r);
}
typedef _Float16 h2_t __attribute__((ext_vector_type(2)));
typedef _Float16 h8_t __attribute__((ext_vector_type(8)));
DI unsigned pack2h(float a, float b) {
  f32x2 v = {a, b};
  h2_t r = __builtin_convertvector(v, h2_t);
  return __builtin_bit_cast(unsigned, r);
}
DI float h_lo(unsigned u) { return (float)__builtin_bit_cast(h2_t, u)[0]; }
DI float h_hi(unsigned u) { return (float)__builtin_bit_cast(h2_t, u)[1]; }
DI int crow(int i, int h) { return (i & 3) + 8 * (i >> 2) + 4 * h; }
typedef const float* cfp_t;
DI cfp_t inp(int i) {
  asm volatile("" : "+s"(i));
  return ((const __attribute__((address_space(4))) cfp_t*)__builtin_amdgcn_kernarg_segment_ptr())[i];
}
DI unsigned char* wsp() { return (unsigned char*)inp(25); }
DI float* outp() { return (float*)inp(24); }
DI int tid_opaque() { int t = threadIdx.x; asm volatile("" : "+v"(t)); return t; }
DI float fexp2(float x) { return __builtin_amdgcn_exp2f(x); }


#define XB_TMO      128
#define XB_XCNT(j)  (256  + 64 * (j))
#define XB_XSUB(j)  (1280 + 64 * (j))
#define XB_XGEN(j)  (2304 + 64 * (j))
#define XB_TOP      3328
#define XB_TOPGEN   3392
#define XCD_BAR_WORDS 3456
#define XB_SPIN_CAP (1u << 20)
#define LAS __attribute__((address_space(3)))
DI unsigned xb_ld(unsigned* p) { return __hip_atomic_load(p, __ATOMIC_RELAXED, __HIP_MEMORY_SCOPE_AGENT); }
DI unsigned xb_add(unsigned* p, unsigned v) { return __hip_atomic_fetch_add(p, v, __ATOMIC_RELAXED, __HIP_MEMORY_SCOPE_AGENT); }
DI unsigned xb_xcc_id() { return (unsigned)__builtin_amdgcn_s_getreg((3 << 11) | 20) & 0xFu; }
#define XB_SPIN(cond, bar) do { unsigned _sp = 0; while (cond) { __builtin_amdgcn_s_sleep(1); \
    if ((++_sp & 255u) == 0u) { if (xb_ld(&(bar)[XB_TMO])) break; if (_sp > XB_SPIN_CAP) { atomicAdd(&(bar)[XB_TMO], 1u); break; } } } } while (0)
struct XcdBarrier { unsigned* bar; unsigned x; volatile LAS unsigned* st; };
DI XcdBarrier xcd_barrier_post(unsigned* bar, volatile LAS unsigned* st) {
  XcdBarrier b; b.bar = bar; b.x = xb_xcc_id(); b.st = st;
  if (threadIdx.x == 0) (void)xb_add(&bar[XB_XCNT(b.x)], 1u);
  return b;
}
DI void xcd_barrier_complete(unsigned* bar, unsigned x, unsigned& nloc, unsigned& nx) {
  const unsigned G = gridDim.x * gridDim.y * gridDim.z;
  unsigned sum, cnt, mine, sp = 0u;
  for (;;) {
    sum = 0u; cnt = 0u; mine = 0u;
#pragma unroll
    for (unsigned j = 0; j < 16; ++j) { const unsigned c = xb_ld(&bar[XB_XCNT(j)]); sum += c; cnt += (c > 0u) ? 1u : 0u; mine = (j == x) ? c : mine; }
    if (sum == G) break;
    __builtin_amdgcn_s_sleep(1);
    if ((++sp & 255u) == 0u) { if (xb_ld(&bar[XB_TMO])) break; if (sp > XB_SPIN_CAP) { atomicAdd(&bar[XB_TMO], 1u); break; } }
  }
  nloc = mine > 0u ? mine : 1u; nx = cnt > 0u ? cnt : 1u;
}
DI void xcd_barrier(const XcdBarrier& b) {
  asm volatile("s_waitcnt vmcnt(0)" ::: "memory");
  __syncthreads();
  if (threadIdx.x == 0) {
    unsigned* bar = b.bar;
    __builtin_amdgcn_s_waitcnt(0);
    unsigned nloc = b.st[0], nx = b.st[1];
    if (nloc == 0u) { xcd_barrier_complete(bar, b.x, nloc, nx); b.st[0] = nloc; b.st[1] = nx; }
    const unsigned old = xb_add(&bar[XB_XSUB(b.x)], 1u);
    const unsigned gen = old / nloc;
    if (old + 1u == (gen + 1u) * nloc) {
      __builtin_amdgcn_fence(__ATOMIC_RELEASE, "agent");
      asm volatile("s_waitcnt vmcnt(0)" ::: "memory");
      const unsigned og = xb_add(&bar[XB_TOP], 1u);
      const unsigned tg = og / nx;
      if (og + 1u == (tg + 1u) * nx) xb_add(&bar[XB_TOPGEN], 1u);
      else XB_SPIN(xb_ld(&bar[XB_TOPGEN]) == tg, bar);
      __builtin_amdgcn_fence(__ATOMIC_ACQUIRE, "agent");
      xb_add(&bar[XB_XGEN(b.x)], 1u);
      asm volatile("s_waitcnt vmcnt(0)" ::: "memory");
    } else {
      XB_SPIN(xb_ld(&bar[XB_XGEN(b.x)]) == gen, bar);
      __builtin_amdgcn_fence(__ATOMIC_ACQUIRE, "agent");
      asm volatile("s_waitcnt vmcnt(0)" ::: "memory");
    }
  }
  __syncthreads();
}

enum { EPI_PLAIN = 0, EPI_IN_AB = 1, EPI_IN_CD = 2, EPI_UQ = 3, EPI_RESID = 4, EPI_GU = 5 };

struct Ep {
  const float* ss;
  int nss;
  float inv_n;
  bf16_t* out;
  int ldo;
  float* xf;
  bf16_t* xb;
  float* ss_out;
  float* ss_cq;
  float* ss_ckv;
  const float* g_a;
  const float* g_b;
  const float2* cs1;
  const float2* cs2;
  const float2* csc;
};

DI void chunk_pair(const float* tr, bf16_t* dst, int A, int B, float sa, const float* g, const float2* cs, bool) {
  float4 a0 = *(const float4*)(tr + A), a1 = *(const float4*)(tr + A + 4);
  float4 b0 = *(const float4*)(tr + B), b1 = *(const float4*)(tr + B + 4);
  float a[8] = {a0.x * sa, a0.y * sa, a0.z * sa, a0.w * sa, a1.x * sa, a1.y * sa, a1.z * sa, a1.w * sa};
  float b[8] = {b0.x * sa, b0.y * sa, b0.z * sa, b0.w * sa, b1.x * sa, b1.y * sa, b1.z * sa, b1.w * sa};
  if (g) {
#pragma unroll
    for (int k = 0; k < 8; ++k) { a[k] *= g[A + k]; b[k] *= g[B + k]; }
  }
  if (cs) {
#pragma unroll
    for (int k = 0; k < 8; ++k) {
      const float2 c = cs[k];
      const float x1 = a[k], x2 = b[k];
      a[k] = x1 * c.x - x2 * c.y;
      b[k] = x1 * c.y + x2 * c.x;
    }
  }
  uint4 ua, ub;
  ua.x = pack2(a[0], a[1]); ua.y = pack2(a[2], a[3]); ua.z = pack2(a[4], a[5]); ua.w = pack2(a[6], a[7]);
  ub.x = pack2(b[0], b[1]); ub.y = pack2(b[2], b[3]); ub.z = pack2(b[4], b[5]); ub.w = pack2(b[6], b[7]);
  *(uint4*)(dst + A) = ua;
  *(uint4*)(dst + B) = ub;
}

template <int EPI>
DI void gemm_epilogue(const Ep& e, int m0, int n0) {
  const int t = tid_opaque();
  const float* rstdL = (const float*)(smem + SMEM_RSTD);
  const float* T = (const float*)smem;
  if constexpr (EPI == EPI_PLAIN) {
#pragma unroll
    for (int p = 0; p < 8; ++p) {
      const int row = p * 32 + (t >> 4), c8 = (t & 15) * 8;
      const float rstd = rstdL[row];
      const float4 a = *(const float4*)(T + row * 132 + c8), b = *(const float4*)(T + row * 132 + c8 + 4);
      uint4 u;
      u.x = pack2(a.x * rstd, a.y * rstd); u.y = pack2(a.z * rstd, a.w * rstd);
      u.z = pack2(b.x * rstd, b.y * rstd); u.w = pack2(b.z * rstd, b.w * rstd);
      *(uint4*)(e.out + (size_t)(m0 + row) * e.ldo + n0 + c8) = u;
    }
    return;
  } else if constexpr (EPI == EPI_RESID) {
#pragma unroll
    for (int p = 0; p < 8; ++p) {
      const int row = p * 32 + (t >> 4), c8 = (t & 15) * 8;
      const float4 a = *(const float4*)(T + row * 132 + c8), b = *(const float4*)(T + row * 132 + c8 + 4);
      bf16_t* bp = e.xb + (size_t)(m0 + row) * DM + n0 + c8;
      const uint4 xo4 = *(const uint4*)bp;
      uint4 u;
      u.x = pack2h(h_lo(xo4.x) + a.x, h_hi(xo4.x) + a.y); u.y = pack2h(h_lo(xo4.y) + a.z, h_hi(xo4.y) + a.w);
      u.z = pack2h(h_lo(xo4.z) + b.x, h_hi(xo4.z) + b.y); u.w = pack2h(h_lo(xo4.w) + b.z, h_hi(xo4.w) + b.w);
      *(uint4*)bp = u;
      const float r0 = h_lo(u.x), r1 = h_hi(u.x), r2 = h_lo(u.y), r3 = h_hi(u.y);
      const float r4 = h_lo(u.z), r5 = h_hi(u.z), r6 = h_lo(u.w), r7 = h_hi(u.w);
      float s2 = r0 * r0 + r1 * r1 + r2 * r2 + r3 * r3 + r4 * r4 + r5 * r5 + r6 * r6 + r7 * r7;
      s2 += __shfl_xor(s2, 1); s2 += __shfl_xor(s2, 2); s2 += __shfl_xor(s2, 4);
      if ((t & 7) == 0) e.ss_out[(size_t)(m0 + row) * 16 + ((n0 + c8) >> 6)] = s2;
    }
    return;
  } else if constexpr (EPI == EPI_GU) {
#pragma unroll
    for (int p = 0; p < 4; ++p) {
      const int row = p * 64 + (t >> 3), o8 = (t & 7) * 8;
      const int gc = (o8 >> 5) * 64 + (o8 & 31);
      const float rstd = rstdL[row];
      const float4 g0 = *(const float4*)(T + row * 132 + gc), g1 = *(const float4*)(T + row * 132 + gc + 4);
      const float4 u0 = *(const float4*)(T + row * 132 + gc + 32), u1 = *(const float4*)(T + row * 132 + gc + 36);
      const float gg[8] = {g0.x, g0.y, g0.z, g0.w, g1.x, g1.y, g1.z, g1.w};
      const float uu[8] = {u0.x, u0.y, u0.z, u0.w, u1.x, u1.y, u1.z, u1.w};
      float r[8];
#pragma unroll
      for (int k = 0; k < 8; ++k) {
        const float g = gg[k] * rstd, u = uu[k] * rstd;
        r[k] = g * __builtin_amdgcn_rcpf(1.f + fexp2(-g * LOG2E)) * u;
      }
      uint4 o;
      o.x = pack2(r[0], r[1]); o.y = pack2(r[2], r[3]); o.z = pack2(r[4], r[5]); o.w = pack2(r[6], r[7]);
      *(uint4*)(e.out + (size_t)(m0 + row) * e.ldo + (n0 >> 1) + o8) = o;
    }
    return;
  }
  const int row = t >> 1, c0 = (t & 1) * 64;
  const int gr = m0 + row;
  const int n = n0 + c0;
  const float* tr = T + row * 132 + c0;
  const float rstd = rstdL[row];
  if constexpr (EPI == EPI_IN_AB || EPI == EPI_IN_CD || EPI == EPI_UQ) {
    bf16_t* dst = e.out + (size_t)gr * e.ldo + n;
    const int pos = gr & (SEQ - 1);
    if constexpr (EPI == EPI_IN_AB) {
      float sa = rstd;
      const float* g = nullptr;
      const float2* cs = nullptr;
      if (n < 640) {
        float s2 = 0.f;
#pragma unroll
        for (int c = 0; c < 16; ++c) {
          float4 a = *(const float4*)(tr + 4 * c);
          s2 += a.x * a.x + a.y * a.y + a.z * a.z + a.w * a.w;
        }
        s2 *= rstd * rstd;
        sa = rstd * rsqrtf(s2 * (1.f / 64.f) + EPS);
        g = (n < 512) ? e.g_a : e.g_b;
        cs = e.cs2 + pos * 32;
      } else if (n >= 768 && n < 1408) {
        cs = e.cs1 + pos * 32;
      }
#pragma unroll
      for (int c = 0; c < 4; ++c) chunk_pair(tr, dst, 8 * c, 32 + 8 * c, sa, g, cs ? cs + 8 * c : nullptr, false);
    } else if constexpr (EPI == EPI_IN_CD) {
      const float2* cs = nullptr;
      bool zb = false;
      if (n < 384) {
        float s2 = 0.f;
#pragma unroll
        for (int c = 0; c < 16; ++c) {
          float4 a = *(const float4*)(tr + 4 * c);
          s2 += a.x * a.x + a.y * a.y + a.z * a.z + a.w * a.w;
        }
        if (n < 256) e.ss_cq[(size_t)gr * 4 + (n >> 6)] = s2 * rstd * rstd;
        else e.ss_ckv[(size_t)gr * 2 + ((n - 256) >> 6)] = s2 * rstd * rstd;
      } else if (n == 384) {
        cs = e.csc + pos * 16;
        zb = true;
      }
      chunk_pair(tr, dst, 0, 16, rstd, nullptr, cs, false);
      chunk_pair(tr, dst, 8, 24, rstd, nullptr, cs ? cs + 8 : nullptr, false);
      chunk_pair(tr, dst, 32, 48, zb ? 0.f : rstd, nullptr, nullptr, false);
      chunk_pair(tr, dst, 40, 56, zb ? 0.f : rstd, nullptr, nullptr, false);
    } else if constexpr (EPI == EPI_UQ) {
      const float2* csr = e.csc + pos * 16;
      const float2* cs_a = (n >= 64 && ((n - 64) % 96) == 0) ? csr : nullptr;
      const float2* cs_b = (((n + 32 - 64) % 96) == 0) ? csr : nullptr;
      chunk_pair(tr, dst, 0, 16, rstd, nullptr, cs_a, false);
      chunk_pair(tr, dst, 8, 24, rstd, nullptr, cs_a ? cs_a + 8 : nullptr, false);
      chunk_pair(tr, dst, 32, 48, rstd, nullptr, cs_b, false);
      chunk_pair(tr, dst, 40, 56, rstd, nullptr, cs_b ? cs_b + 8 : nullptr, false);
    }
  }
}

DI int lds_byte8(int r, int c) {
  const int st = (r >> 4) * 2 + (c >> 5), rr = r & 15, cc = c & 31, ob = rr * 64 + cc * 2;
  return st * 1024 + (ob ^ (((ob >> 9) & 1) << 5));
}
DI void stage_rc8(int b, int& R, int& C) {
  const int st = b / 1024, sb = b % 1024, swz = sb ^ (((sb >> 9) & 1) << 5);
  R = (st >> 1) * 16 + swz / 64; C = (st & 1) * 32 + (swz % 64) / 2;
}
template <int EPI, bool F16>
DI void gemm_tile256(const bf16_t* __restrict__ A, int lda, const bf16_t* __restrict__ Bt, int K, int m0, int n0, const Ep& e,
                     bool pre = false, int nm0 = -1, int nn0 = 0) {
  constexpr int HT = 128 * 64;
  bf16_t* shm = (bf16_t*)smem;
  const int t = tid_opaque();
#define SA8(b, h) (shm + ((b) * 2 + (h)) * HT)
#define SB8(b, h) (shm + (4 + (b) * 2 + (h)) * HT)
#define STAGE8(P, BASE, LD, br, kt) do { const long _g = (long)(br) * (LD) + (long)(kt) * 64;              \
    _Pragma("unroll") for (int _i = 0; _i < 2; ++_i) { const int _b = t * 16 + _i * 8192; int _r, _c; stage_rc8(_b, _r, _c); \
      __builtin_amdgcn_global_load_lds((const unsigned*)((BASE) + _g + (long)_r * (LD) + _c),              \
                                       (unsigned*)((char*)(P) + _b), 16, 0, 0); } } while (0)
#define LDA8(dst, b, h) _Pragma("unroll") for (int m = 0; m < 4; ++m) _Pragma("unroll") for (int k = 0; k < 2; ++k) \
    dst[m][k] = *(const bf16x8*)((const char*)SA8(b, h) + lds_byte8(wr * 64 + m * 16 + fr, k * 32 + fq * 8))
#define LDB8(dst, b, h) _Pragma("unroll") for (int n = 0; n < 2; ++n) _Pragma("unroll") for (int k = 0; k < 2; ++k) \
    dst[n][k] = *(const bf16x8*)((const char*)SB8(b, h) + lds_byte8(wc * 32 + n * 16 + fr, k * 32 + fq * 8))
#define MF8(a, b, c) (F16 ? __builtin_amdgcn_mfma_f32_16x16x32_f16(__builtin_bit_cast(h8_t, a), __builtin_bit_cast(h8_t, b), c, 0, 0, 0) \
                          : __builtin_amdgcn_mfma_f32_16x16x32_bf16(a, b, c, 0, 0, 0))
#define MMA8(ai, bj, AT, BT) do { __builtin_amdgcn_s_setprio(1);                                           \
    _Pragma("unroll") for (int m = 0; m < 4; ++m) _Pragma("unroll") for (int n = 0; n < 2; ++n) _Pragma("unroll") for (int k = 0; k < 2; ++k) \
      acc[ai][bj][m][n] = MF8(AT[m][k], BT[n][k], acc[ai][bj][m][n]);                                      \
    __builtin_amdgcn_s_setprio(0); } while (0)
#define WAIT_V8(n) asm volatile("s_waitcnt vmcnt(" #n ")" ::: "memory")
#define WAIT_L8(n) asm volatile("s_waitcnt lgkmcnt(" #n ")" ::: "memory")
#define BAR8 __builtin_amdgcn_s_barrier()
#define SCHED8 __builtin_amdgcn_sched_barrier(0)
  const int brow = m0, bcol = n0;
  const int wid = t >> 6, lane = t & 63, wr = wid >> 2, wc = wid & 3, fr = lane & 15, fq = lane >> 4;
  f32x4 acc[2][2][4][2];
  {
    float zinit = 0.f;
    asm volatile("" : "+v"(zinit));
#pragma unroll
    for (int a = 0; a < 2; ++a)
#pragma unroll
      for (int b = 0; b < 2; ++b)
#pragma unroll
        for (int m = 0; m < 4; ++m)
#pragma unroll
          for (int n = 0; n < 2; ++n)
#pragma unroll
            for (int j = 0; j < 4; ++j) acc[a][b][m][n][j] = zinit;
  }
  bf16x8 At[4][2], B0[2][2], B1[2][2];
  const int nt = K / 64;
  if (!pre) {
    STAGE8(SB8(0, 0), Bt, K, bcol, 0); STAGE8(SA8(0, 0), A, lda, brow, 0);
    STAGE8(SB8(0, 1), Bt, K, bcol + 128, 0); STAGE8(SA8(0, 1), A, lda, brow + 128, 0);
  }
  if (wr == 1) BAR8;
  WAIT_V8(4); BAR8;
  STAGE8(SB8(1, 0), Bt, K, bcol, 1); STAGE8(SA8(1, 0), A, lda, brow, 1); STAGE8(SB8(1, 1), Bt, K, bcol + 128, 1);
  WAIT_V8(6); BAR8;
  for (int tt = 0; tt < nt - 2; tt += 2) {
    LDB8(B0, 0, 0); SCHED8; LDA8(At, 0, 0); STAGE8(SA8(1, 1), A, lda, brow + 128, tt + 1);
    WAIT_L8(8); BAR8; WAIT_L8(0); MMA8(0, 0, At, B0); BAR8; SCHED8;
    LDB8(B1, 0, 1); STAGE8(SB8(0, 0), Bt, K, bcol, tt + 2);
    BAR8; WAIT_L8(0); MMA8(0, 1, At, B1); BAR8;
    LDA8(At, 0, 1); STAGE8(SA8(0, 0), A, lda, brow, tt + 2);
    BAR8; WAIT_L8(0); MMA8(1, 0, At, B0); BAR8; SCHED8;
    STAGE8(SB8(0, 1), Bt, K, bcol + 128, tt + 2);
    WAIT_V8(6); BAR8; MMA8(1, 1, At, B1); BAR8;
    LDB8(B0, 1, 0); SCHED8; LDA8(At, 1, 0); STAGE8(SA8(0, 1), A, lda, brow + 128, tt + 2);
    WAIT_L8(8); BAR8; WAIT_L8(0); MMA8(0, 0, At, B0); BAR8; SCHED8;
    LDB8(B1, 1, 1); STAGE8(SB8(1, 0), Bt, K, bcol, tt + 3);
    BAR8; WAIT_L8(0); MMA8(0, 1, At, B1); BAR8;
    LDA8(At, 1, 1); STAGE8(SA8(1, 0), A, lda, brow, tt + 3);
    BAR8; WAIT_L8(0); MMA8(1, 0, At, B0); BAR8; SCHED8;
    STAGE8(SB8(1, 1), Bt, K, bcol + 128, tt + 3);
    WAIT_V8(6); BAR8; MMA8(1, 1, At, B1); BAR8;
  }
  { LDB8(B0, 0, 0); LDA8(At, 0, 0); STAGE8(SA8(1, 1), A, lda, brow + 128, nt - 1);
    BAR8; WAIT_L8(0); MMA8(0, 0, At, B0); BAR8;
    LDB8(B1, 0, 1); BAR8; WAIT_L8(0); MMA8(0, 1, At, B1); BAR8;
    LDA8(At, 0, 1); WAIT_V8(4); BAR8; WAIT_L8(0); MMA8(1, 0, At, B0); MMA8(1, 1, At, B1); BAR8; }
  { LDB8(B0, 1, 0); LDA8(At, 1, 0); WAIT_V8(2); BAR8; WAIT_L8(0); MMA8(0, 0, At, B0); BAR8;
    LDB8(B1, 1, 1); WAIT_V8(0); BAR8; WAIT_L8(0); MMA8(0, 1, At, B1); BAR8;
    LDA8(At, 1, 1); BAR8; WAIT_L8(0); MMA8(1, 0, At, B0); MMA8(1, 1, At, B1); BAR8; }
  if (wr == 0) BAR8;
  __syncthreads();
  if (EPI == EPI_GU && nm0 >= 0) {
    const int t = tid_opaque();
    STAGE8(SB8(0, 0), Bt, K, nn0, 0); STAGE8(SA8(0, 0), A, lda, nm0, 0);
    STAGE8(SB8(0, 1), Bt, K, nn0 + 128, 0); STAGE8(SA8(0, 1), A, lda, nm0 + 128, 0);
  }
#undef SA8
#undef SB8
#undef STAGE8
#undef LDA8
#undef LDB8
#undef MF8
#undef MMA8
#undef WAIT_V8
#undef WAIT_L8
#undef BAR8
#undef SCHED8
  if (t < 256) {
    float rs = 1.f;
    if (e.ss) {
      const float* sp = e.ss + (size_t)(m0 + t) * e.nss;
      float s = 0.f;
      for (int i = 0; i < e.nss; ++i) s += sp[i];
      rs = rsqrtf(s * e.inv_n + EPS);
    }
    ((float*)(smem + SMEM_RSTD))[t] = rs;
  }
  if constexpr (EPI == EPI_GU) {
    __syncthreads();
    const float* rstdL = (const float*)(smem + SMEM_RSTD);
#pragma unroll
    for (int ai = 0; ai < 2; ++ai)
#pragma unroll
      for (int m = 0; m < 4; ++m) {
        const int rowb = ai * 128 + wr * 64 + m * 16 + fq * 4;
        const f32x4 rs4 = *(const f32x4*)(rstdL + rowb);
#pragma unroll
        for (int bj = 0; bj < 2; ++bj) {
          bf16_t* op = e.out + (size_t)(m0 + rowb) * e.ldo + ((n0 + bj * 128 + wc * 32) >> 1) + fr;
#pragma unroll
          for (int j = 0; j < 4; ++j) {
            const float g = acc[ai][bj][m][0][j] * rs4[j], u = acc[ai][bj][m][1][j] * rs4[j];
            const float rv = g * __builtin_amdgcn_rcpf(1.f + fexp2(-g * LOG2E)) * u;
            op[(size_t)j * e.ldo] = (bf16_t)(pack2(rv, 0.f) & 0xffffu);
          }
        }
      }
    __syncthreads();
    return;
  }
  float* T = (float*)smem;
#pragma unroll
  for (int bj = 0; bj < 2; ++bj) {
#pragma unroll
    for (int ai = 0; ai < 2; ++ai)
#pragma unroll
      for (int m = 0; m < 4; ++m)
#pragma unroll
        for (int n = 0; n < 2; ++n)
#pragma unroll
          for (int j = 0; j < 4; ++j)
            T[(ai * 128 + wr * 64 + m * 16 + fq * 4 + j) * 132 + wc * 32 + n * 16 + fr] = acc[ai][bj][m][n][j];
    __syncthreads();
    gemm_epilogue<EPI>(e, m0, n0 + bj * 128);
    __syncthreads();
  }
}

template <int EPI, int BN, bool F16>
DI void gemm_tile(const bf16_t* __restrict__ A, int lda, const bf16_t* __restrict__ W, int K, int m0, int n0, const Ep& e) {
  if constexpr (BN == 256) { gemm_tile256<EPI, F16>(A, lda, W, K, m0, n0, e); return; }
  constexpr int MI = (BN == 256) ? 4 : 2;
  constexpr int NPB = BN / 64;
  const int t = tid_opaque(), l = t & 63, w = t >> 6, r = l & 31, h = l >> 5;
  const int wm = (BN == 256) ? (w >> 2) : (w >> 1), wn = (BN == 256) ? (w & 3) : (w & 1);
  f32x16 acc[MI][2];
#pragma unroll
  for (int i = 0; i < MI; ++i)
#pragma unroll
    for (int j = 0; j < 2; ++j)
#pragma unroll
      for (int k = 0; k < 16; ++k) acc[i][j][k] = 0.f;

  const int grow = w * 8 + (l >> 3);
  const int gch = (l & 7) ^ ((grow >> 1) & 7);
  const bf16_t* ap = A + (size_t)(m0 + grow) * lda + gch * 8;
  const bf16_t* wp = W + (size_t)(n0 + grow) * K + gch * 8;
  unsigned char* lbase = smem + w * 1024;
  const int sw = (r >> 1) & 7;
  const unsigned char* ab = smem + (wm * (MI * 32) + r) * 128;
  const unsigned char* bb = smem + 32768 + (wn * 64 + r) * 128;
  const int nk = K >> 6;
#define G_STAGE(BUF, KT)                                                                              \
  _Pragma("unroll") for (int i = 0; i < 4; ++i) {                                                     \
    __builtin_amdgcn_global_load_lds((const unsigned*)(ap + (size_t)(64 * i) * lda + (KT) * 64),      \
                                     (unsigned*)(lbase + (BUF) * 65536 + i * 8192), 16, 0, 0);        \
    if (i < NPB)                                                                                      \
    __builtin_amdgcn_global_load_lds((const unsigned*)(wp + (size_t)(64 * i) * K + (KT) * 64),        \
                                     (unsigned*)(lbase + (BUF) * 65536 + 32768 + i * 8192), 16, 0, 0);\
  }
#define G_READ(FA, FB, BUF, KS)                                                   \
  {                                                                               \
    const int co = ((2 * (KS) + h) ^ sw) << 4;                                    \
    _Pragma("unroll") for (int mi = 0; mi < MI; ++mi)                             \
      FA[mi] = *(const bf16x8*)(ab + (BUF) * 65536 + mi * 32 * 128 + co);         \
    _Pragma("unroll") for (int ni = 0; ni < 2; ++ni)                              \
      FB[ni] = *(const bf16x8*)(bb + (BUF) * 65536 + ni * 32 * 128 + co);         \
  }
#define G_MMA(FA, FB)                                                             \
  _Pragma("unroll") for (int mi = 0; mi < MI; ++mi)                               \
    _Pragma("unroll") for (int ni = 0; ni < 2; ++ni)                              \
      acc[mi][ni] = F16 ? __builtin_amdgcn_mfma_f32_32x32x16_f16(__builtin_bit_cast(h8_t, FA[mi]), __builtin_bit_cast(h8_t, FB[ni]), acc[mi][ni], 0, 0, 0) \
                        : MFMA32(FA[mi], FB[ni], acc[mi][ni]);
#define G_INTERLEAVE()                                                            \
  _Pragma("unroll") for (int q = 0; q < MI + 2; ++q) {                            \
    __builtin_amdgcn_sched_group_barrier(0x008, 1, 0);                            \
    __builtin_amdgcn_sched_group_barrier(0x100, 1, 0);                            \
  }                                                                               \
  if (MI > 2) __builtin_amdgcn_sched_group_barrier(0x008, MI - 2, 0);
#define G_COMPUTE(BUF)                                                            \
  {                                                                               \
    bf16x8 fa0[MI], fb0[2], fa1[MI], fb1[2];                                      \
    G_READ(fa0, fb0, BUF, 0)                                                      \
    G_READ(fa1, fb1, BUF, 1)                                                      \
    G_MMA(fa0, fb0)                                                               \
    G_INTERLEAVE()                                                                \
    G_READ(fa0, fb0, BUF, 2)                                                      \
    G_MMA(fa1, fb1)                                                               \
    G_INTERLEAVE()                                                                \
    G_READ(fa1, fb1, BUF, 3)                                                      \
    G_MMA(fa0, fb0)                                                               \
    G_INTERLEAVE()                                                                \
    G_MMA(fa1, fb1)                                                               \
  }
#define WAIT_V0() asm volatile("s_waitcnt vmcnt(0)" ::: "memory")
  G_STAGE(0, 0)
  WAIT_V0();
  __syncthreads();
  for (int kt = 0; kt < nk; kt += 2) {
    G_STAGE(1, kt + 1)
    G_COMPUTE(0)
    WAIT_V0();
    __syncthreads();
    if (kt + 2 < nk) { G_STAGE(0, kt + 2) }
    G_COMPUTE(1)
    WAIT_V0();
    __syncthreads();
  }
#undef G_STAGE
#undef G_COMPUTE
#undef G_READ
#undef G_MMA
#undef G_INTERLEAVE
#undef WAIT_V0
  if (t < 256) {
    float rs = 1.f;
    if (e.ss) {
      const float* sp = e.ss + (size_t)(m0 + t) * e.nss;
      float s = 0.f;
      for (int i = 0; i < e.nss; ++i) s += sp[i];
      rs = rsqrtf(s * e.inv_n + EPS);
    }
    ((float*)(smem + SMEM_RSTD))[t] = rs;
  }
  float* T = (float*)smem;
#pragma unroll
  for (int bj = 0; bj < BN / 128; ++bj) {
    if (BN == 128 || (wn >> 1) == bj) {
      const int cb = (BN == 128) ? wn * 64 : (wn & 1) * 64;
#pragma unroll
      for (int mi = 0; mi < MI; ++mi)
#pragma unroll
        for (int ni = 0; ni < 2; ++ni)
#pragma unroll
          for (int i = 0; i < 16; ++i)
            T[(wm * (MI * 32) + mi * 32 + crow(i, h)) * 132 + cb + ni * 32 + r] = acc[mi][ni][i];
    }
    __syncthreads();
    gemm_epilogue<EPI>(e, m0, n0 + bj * 128);
    __syncthreads();
  }
}

struct AttArgs {
  const bf16_t* q; int ldq;
  const bf16_t* k; int ldk;
  const bf16_t* k2; int ldk2;
  const bf16_t* v; int ldv;
  bf16_t* o; int ldo;
  float scale;
  float sink;
  const float* sinkp;
  const float* rpb;
};

template <int DK, int DV, int MODE>
DI void att_gload(const AttArgs& a, int tile, u32x4 (&kr)[(64 * (DK / 8) + NT - 1) / NT], u32x4 (&vr)[(64 * (DV / 8) + NT - 1) / NT]) {
  constexpr int CK = DK / 8, CV = DV / 8;
  constexpr int NKL = (64 * CK + NT - 1) / NT, NVL = (64 * CV + NT - 1) / NT;
  const int t = tid_opaque();
  const int kbase = tile * 64;
#pragma unroll
  for (int i = 0; i < NKL; ++i) {
    const int id = min(t + NT * i, 64 * CK - 1);
    const int row = id / CK, c = id % CK;
    if constexpr (MODE == 3) {
      const bf16_t* src = (c < 8) ? (a.k + (size_t)(kbase + row) * a.ldk + c * 8) : (a.k2 + (size_t)(kbase + row) * a.ldk2 + (c - 8) * 8);
      kr[i] = *(const u32x4*)src;
    } else {
      kr[i] = *(const u32x4*)(a.k + (size_t)(kbase + row) * a.ldk + c * 8);
    }
  }
#pragma unroll
  for (int i = 0; i < NVL; ++i) {
    const int id = t + NT * i;
    const int row = id / CV, c = id % CV;
    vr[i] = *(const u32x4*)(a.v + (size_t)(kbase + row) * a.ldv + c * 8);
  }
}
template <int DK, int DV>
DI void att_swrite(int buf, const u32x4 (&kr)[(64 * (DK / 8) + NT - 1) / NT], const u32x4 (&vr)[(64 * (DV / 8) + NT - 1) / NT]) {
  constexpr int CK = DK / 8, CV = DV / 8;
  constexpr int KST = DK * 2 + 16, VST = DV * 2 + 16;
  constexpr int KBYTES = 64 * KST, VBYTES = 64 * VST, BUFB = KBYTES + VBYTES;
  constexpr int NKL = (64 * CK + NT - 1) / NT, NVL = (64 * CV + NT - 1) / NT;
  const int t = tid_opaque();
#pragma unroll
  for (int i = 0; i < NKL; ++i) {
    const int id = t + NT * i;
    const int row = id / CK, c = id % CK;
    if (id < 64 * CK) *(u32x4*)(smem + buf * BUFB + row * KST + c * 16) = kr[i];
  }
#pragma unroll
  for (int i = 0; i < NVL; ++i) {
    const int id = t + NT * i;
    const int row = id / CV, c = id % CV;
    *(u32x4*)(smem + buf * BUFB + KBYTES + row * VST + c * 16) = vr[i];
  }
}

template <int DK, int DV, int MODE, int QB, bool PACK = false>
DI void attn_item(const AttArgs& a, int q0, int t_lo, int t_hi) {
  constexpr int CK = DK / 8, CV = DV / 8;
  constexpr int KST = DK * 2 + 16, VST = DV * 2 + 16;
  constexpr int KBYTES = 64 * KST, VBYTES = 64 * VST, BUFB = KBYTES + VBYTES;
  constexpr int NKL = (64 * CK + NT - 1) / NT, NVL = (64 * CV + NT - 1) / NT;
  constexpr int NKS = DK / 16, NDB = DV / 32;
  static_assert(2 * BUFB + 2048 <= SMEM_MAIN, "lds");
  static_assert((64 * CV) % NT == 0, "v chunks");
  const int t = tid_opaque(), l = t & 63, w = t >> 6, r = l & 31, h = l >> 5;
  float* rpbs = (float*)(smem + 2 * BUFB);
  const int hg = PACK ? (w >> 1) : 0;
  const int wq0 = PACK ? q0 + (w & 1) * (32 * QB) : q0 + w * (32 * QB);

  int rq = 0, r0 = 0, cq[QB], c0[QB];
#pragma unroll
  for (int qb = 0; qb < QB; ++qb) { cq[qb] = 0; c0[qb] = 0; }
  if constexpr (MODE == 2) {
    rq = wq0 >> 6;
    r0 = min(max(rq - 4, 0), 24);
#pragma unroll
    for (int qb = 0; qb < QB; ++qb) {
      cq[qb] = ((wq0 + qb * 32) & 63) + r;
      c0[qb] = min(max(cq[qb] - 8, 0), 48);
    }
    for (int i = t; i < 465; i += NT) rpbs[i] = a.rpb[i];
  }

  bf16x8 qf[QB][NKS];
#pragma unroll
  for (int qb = 0; qb < QB; ++qb) {
    const bf16_t* qp = a.q + hg * DK + (size_t)(wq0 + qb * 32 + r) * a.ldq + h * 8;
#pragma unroll
    for (int s = 0; s < NKS; ++s) qf[qb][s] = *(const bf16x8*)(qp + s * 16);
  }
  f32x16 o[QB][NDB];
  float m[QB], lsum[QB];
#pragma unroll
  for (int qb = 0; qb < QB; ++qb) {
    m[qb] = -1e30f; lsum[qb] = 0.f;
#pragma unroll
    for (int d = 0; d < NDB; ++d)
#pragma unroll
      for (int i = 0; i < 16; ++i) o[qb][d][i] = 0.f;
  }

  u32x4 kr[NKL], vr[NVL];
  att_gload<DK, DV, MODE>(a, t_lo, kr, vr);
  att_swrite<DK, DV>(0, kr, vr);
  if (t_lo + 1 < t_hi) att_gload<DK, DV, MODE>(a, t_lo + 1, kr, vr);
  __syncthreads();
  const float scale = a.scale;
  const float cexp = (MODE == 2) ? LOG2E : a.scale * LOG2E;
  const int vq = (l & 15) >> 2, vp = l & 3, vblk = (l >> 4) & 1;
  for (int tile = t_lo; tile < t_hi; ++tile) {
    const int buf = (tile - t_lo) & 1;
    if (tile + 1 < t_hi) att_swrite<DK, DV>(buf ^ 1, kr, vr);
    if (tile + 2 < t_hi) att_gload<DK, DV, MODE>(a, tile + 2, kr, vr);
    const unsigned char* Kb = smem + buf * BUFB;
    const unsigned char* Vb = Kb + KBYTES;
    bool active = true;
    if constexpr (MODE == 2) active = (tile >= r0) && (tile < r0 + 8);
    if constexpr (MODE == 1) active = (tile * 64 + 63 >= wq0 - 128) && (tile * 64 <= wq0 + 32 * QB - 1 + 128);
    if (active) {
      f32x16 s[QB][2];
#pragma unroll
      for (int kb = 0; kb < 2; ++kb) {
#pragma unroll
        for (int qb = 0; qb < QB; ++qb)
#pragma unroll
          for (int i = 0; i < 16; ++i) s[qb][kb][i] = 0.f;
        const unsigned char* kp = Kb + (kb * 32 + r) * KST + h * 16;
#pragma unroll
        for (int st = 0; st < NKS; ++st) {
          const bf16x8 kf = *(const bf16x8*)(kp + st * 32);
#pragma unroll
          for (int qb = 0; qb < QB; ++qb) s[qb][kb] = MFMA32(kf, qf[qb][st], s[qb][kb]);
        }
      }
#pragma unroll
      for (int qb = 0; qb < QB; ++qb) {
        const int qidx = wq0 + qb * 32 + r;
        float mloc = -1e30f;
#pragma unroll
        for (int kb = 0; kb < 2; ++kb)
#pragma unroll
          for (int i = 0; i < 16; ++i) {
            float tt = s[qb][kb][i];
            if constexpr (MODE == 1) {
              const int kidx = tile * 64 + kb * 32 + crow(i, h);
              const int d = kidx - qidx;
              tt = (d <= 128 && d >= -128) ? tt : -1e30f;
              s[qb][kb][i] = tt;
            }
            if constexpr (MODE == 2) {
              const int kc = kb * 32 + crow(i, h);
              const bool ok = (kc >= c0[qb]) && (kc < c0[qb] + 16);
              const int bi = ok ? ((tile - rq + 7) * 31 + kc - cq[qb] + 15) : 0;
              tt = ok ? fmaf(tt, scale, rpbs[bi]) : -1e30f;
              s[qb][kb][i] = tt;
            }
            mloc = fmaxf(mloc, tt);
          }
        mloc = fmaxf(mloc, __shfl_xor(mloc, 32));
        if (__any((mloc - m[qb]) * cexp > 16.f)) {
          const float mnew = fmaxf(m[qb], mloc);
          const float alpha = fexp2((m[qb] - mnew) * cexp);
          m[qb] = mnew;
          lsum[qb] *= alpha;
#pragma unroll
          for (int d = 0; d < NDB; ++d)
#pragma unroll
            for (int i = 0; i < 16; ++i) o[qb][d][i] *= alpha;
        }
        const float mc = -m[qb] * cexp;
        const f32x2 c2 = {cexp, cexp}, mc2 = {mc, mc};
        f32x2 ps2 = {0.f, 0.f};
#pragma unroll
        for (int kb = 0; kb < 2; ++kb)
#pragma unroll
          for (int i = 0; i < 16; i += 2) {
            const f32x2 sv = {s[qb][kb][i], s[qb][kb][i + 1]};
            const f32x2 e2 = sv * c2 + mc2;
            f32x2 pv = {fexp2(e2[0]), fexp2(e2[1])};
            if constexpr (MODE == 1 || MODE == 2) {
              pv[0] = (sv[0] > -1e29f) ? pv[0] : 0.f;
              pv[1] = (sv[1] > -1e29f) ? pv[1] : 0.f;
            }
            s[qb][kb][i] = pv[0];
            s[qb][kb][i + 1] = pv[1];
            ps2 += pv;
          }
        lsum[qb] += ps2[0] + ps2[1];
      }
#pragma unroll
      for (int qb = 0; qb < QB; ++qb)
#pragma unroll
        for (int kb = 0; kb < 2; ++kb)
#pragma unroll
          for (int st = 0; st < 2; ++st) {
            u32x4 pk;
            pk[0] = pack2(s[qb][kb][8 * st + 0], s[qb][kb][8 * st + 1]);
            pk[1] = pack2(s[qb][kb][8 * st + 2], s[qb][kb][8 * st + 3]);
            pk[2] = pack2(s[qb][kb][8 * st + 4], s[qb][kb][8 * st + 5]);
            pk[3] = pack2(s[qb][kb][8 * st + 6], s[qb][kb][8 * st + 7]);
            const bf16x8 pf = __builtin_bit_cast(bf16x8, pk);
            const unsigned char* vrow = Vb + (kb * 32 + 16 * st + 4 * h + vq) * VST + (16 * vblk + 4 * vp) * 2;
#pragma unroll
            for (int d = 0; d < NDB; ++d) {
              s16x4 lo = __builtin_amdgcn_ds_read_tr16_b64_v4i16((s16x4 __attribute__((address_space(3)))*)(vrow + d * 64));
              s16x4 hi = __builtin_amdgcn_ds_read_tr16_b64_v4i16((s16x4 __attribute__((address_space(3)))*)(vrow + 8 * VST + d * 64));
              const bf16x8 vf = __builtin_shufflevector(lo, hi, 0, 1, 2, 3, 4, 5, 6, 7);
              o[qb][d] = MFMA32(vf, pf, o[qb][d]);
            }
          }
    }
    __syncthreads();
  }
#pragma unroll
  for (int qb = 0; qb < QB; ++qb) {
    float lt = lsum[qb] + __shfl_xor(lsum[qb], 32);
    if constexpr (MODE == 1) lt += fexp2(((PACK ? a.sinkp[hg] : a.sink) - m[qb] * scale) * LOG2E);
    const float inv = 1.f / lt;
    bf16_t* op = a.o + hg * DV + (size_t)(wq0 + qb * 32 + r) * a.ldo + 8 * h;
#pragma unroll
    for (int d = 0; d < NDB; ++d)
#pragma unroll
      for (int pr = 0; pr < 2; ++pr) {
        const int ia = 8 * pr, ib = 8 * pr + 4;
        const unsigned ax = pack2(o[qb][d][ia] * inv, o[qb][d][ia + 1] * inv), ay = pack2(o[qb][d][ia + 2] * inv, o[qb][d][ia + 3] * inv);
        const unsigned bx = pack2(o[qb][d][ib] * inv, o[qb][d][ib + 1] * inv), by = pack2(o[qb][d][ib + 2] * inv, o[qb][d][ib + 3] * inv);
        const u32x2 sx = __builtin_amdgcn_permlane32_swap(ax, bx, false, false);
        const u32x2 sy = __builtin_amdgcn_permlane32_swap(ay, by, false, false);
        uint4 st;
        st.x = sx[0]; st.y = sy[0]; st.z = sx[1]; st.w = sy[1];
        *(uint4*)(op + 32 * d + 16 * pr) = st;
      }
  }
}

DI int map_col(int mode, int n) {
  if (mode == 1) return n < 416 ? n : n + 96;
  if (mode == 2) {
    const int up = n >= 2816 ? 1 : 0;
    const int j = n - up * 2816;
    if (j < 2560) return (j >> 4) * 32 + up * 16 + (j & 15);
    const int jj = j - 2560;
    return 5120 + (jj >> 5) * 64 + up * 32 + (jj & 31);
  }
  return n;
}

DI void convert_tile(const float* __restrict__ W, int K, int N, const float* __restrict__ g, bf16_t* __restrict__ Wt, int mode, int kt, int nt, bool f16) {
  const int t = tid_opaque();
  float* tile = (float*)smem;
  {
    const int nl = (t & 31) * 4;
    const int n = nt * 128 + nl;
    const int nc = min(n, N - 4);
    float4 v[4];
#pragma unroll
    for (int i = 0; i < 4; ++i) v[i] = *(const float4*)(W + (size_t)(kt * 64 + (t >> 5) + 16 * i) * N + nc);
#pragma unroll
    for (int i = 0; i < 4; ++i) {
      const int kl = (t >> 5) + 16 * i;
      const float gs = g ? g[kt * 64 + kl] : 1.f;
      tile[kl * 129 + nl + 0] = v[i].x * gs;
      tile[kl * 129 + nl + 1] = v[i].y * gs;
      tile[kl * 129 + nl + 2] = v[i].z * gs;
      tile[kl * 129 + nl + 3] = v[i].w * gs;
    }
  }
  __syncthreads();
  {
    const int nl = t >> 2, kc = (t & 3) * 16;
    const int n = nt * 128 + nl;
    if (n < N) {
      float v[16];
#pragma unroll
      for (int j = 0; j < 16; ++j) v[j] = tile[(kc + j) * 129 + nl];
      bf16_t* dst = Wt + (size_t)map_col(mode, n) * K + kt * 64 + kc;
      uint4 u0, u1;
      if (f16) {
        u0.x = pack2h(v[0], v[1]); u0.y = pack2h(v[2], v[3]); u0.z = pack2h(v[4], v[5]); u0.w = pack2h(v[6], v[7]);
        u1.x = pack2h(v[8], v[9]); u1.y = pack2h(v[10], v[11]); u1.z = pack2h(v[12], v[13]); u1.w = pack2h(v[14], v[15]);
      } else {
        u0.x = pack2(v[0], v[1]); u0.y = pack2(v[2], v[3]); u0.z = pack2(v[4], v[5]); u0.w = pack2(v[6], v[7]);
        u1.x = pack2(v[8], v[9]); u1.y = pack2(v[10], v[11]); u1.z = pack2(v[12], v[13]); u1.w = pack2(v[14], v[15]);
      }
      *(uint4*)dst = u0;
      *(uint4*)(dst + 8) = u1;
    }
  }
  __syncthreads();
}

DI void convert_mat(const float* W, int K, int N, const float* g, bf16_t* Wt, int mode, int& off, int vb, int nb, bool f16 = false) {
  const int ntn = (N + 127) >> 7;
  const int ntiles = (K >> 6) * ntn;
  const int first = (int)((vb + nb - (off % nb)) % nb);
  for (int i = first; i < ntiles; i += nb) convert_tile(W, K, N, g, Wt, mode, i / ntn, i % ntn, f16);
  off += ntiles;
}

DI void convert_layer(int L, int vb, int vnb) {
  bf16_t* wb = (bf16_t*)(wsp() + OFF_W) + (size_t)(L & 1) * WSZ;
  const int j = L >> 1;
  int off = 0;
  if ((L & 1) == 0) {
    convert_mat(inp(3) + (size_t)j * 1024 * 1536, 1024, 1536, inp(2) + L * 1024, wb + W_IN, 0, off, vb, vnb, true);
    convert_mat(inp(7) + (size_t)j * 1024 * 1024, 1024, 1024, nullptr, wb + W_OUT, 0, off, vb, vnb);
  } else {
    convert_mat(inp(8) + (size_t)j * 1024 * 1952, 1024, 1952, inp(2) + L * 1024, wb + W_IN, 1, off, vb, vnb, true);
    convert_mat(inp(11) + (size_t)j * 256 * 768, 256, 768, inp(9) + j * 256, wb + W_UQ, 0, off, vb, vnb);
    convert_mat(inp(12) + (size_t)j * 128 * 1024, 128, 1024, inp(10) + j * 128, wb + W_UKV, 0, off, vb, vnb);
    convert_mat(inp(14) + (size_t)j * 1024 * 1024, 1024, 1024, nullptr, wb + W_OUT, 0, off, vb, vnb);
    unsigned zz = 0u;
    asm volatile("" : "+v"(zz));
    uint4 z4 = {zz, zz, zz, zz};
    uint4* zp = (uint4*)(wb + W_IN + (size_t)416 * 1024);
    for (int i = vb * NT + tid_opaque(); i < 96 * 1024 / 8; i += vnb * NT) zp[i] = z4;
  }
  convert_mat(inp(17) + (size_t)L * 1024 * 512, 1024, 512, inp(15) + L * 1024, wb + W_XQ, 0, off, vb, vnb, true);
  convert_mat(inp(18) + (size_t)L * 1024 * 1024, 1024, 1024, inp(16) + L * 1024, wb + W_XKV, 0, off, vb, vnb);
  convert_mat(inp(19) + (size_t)L * 512 * 1024, 512, 1024, nullptr, wb + W_XO, 0, off, vb, vnb);
  convert_mat(inp(21) + (size_t)L * 1024 * 5632, 1024, 5632, inp(20) + L * 1024, wb + W_GU, 2, off, vb, vnb, true);
  convert_mat(inp(22) + (size_t)L * 2816 * 1024, 2816, 1024, nullptr, wb + W_DOWN, 0, off, vb, vnb);
}

DI void row_prep(const float* __restrict__ src, float* __restrict__ dstf, bf16_t* __restrict__ dstb, float* __restrict__ ssq, int nslots, int nrows, bool f16) {
  const int t = tid_opaque(), l = t & 63, w = t >> 6;
  for (int row = blockIdx.x * 8 + w; row < nrows; row += gridDim.x * 8) {
    const float4* sp = (const float4*)(src + (size_t)row * DM);
    float s2 = 0.f;
#pragma unroll
    for (int i = 0; i < 4; ++i) {
      float4 v = sp[l + 64 * i];
      s2 += v.x * v.x + v.y * v.y + v.z * v.z + v.w * v.w;
      if (dstf) ((float4*)(dstf + (size_t)row * DM))[l + 64 * i] = v;
      uint2 u;
      if (f16) { u.x = pack2h(v.x, v.y); u.y = pack2h(v.z, v.w); } else { u.x = pack2(v.x, v.y); u.y = pack2(v.z, v.w); }
      ((uint2*)(dstb + (size_t)row * DM))[l + 64 * i] = u;
    }
#pragma unroll
    for (int o = 32; o; o >>= 1) s2 += __shfl_xor(s2, o);
    if (l < nslots) ssq[(size_t)row * nslots + l] = (l == 0) ? s2 : 0.f;
  }
}

DI double dpow(double c, int n) { double r = 1.0; for (int i = 0; i < n; ++i) r *= c; return r; }
DI float2 cossin(double ang) {
  double rev = ang * 0.15915494309189535;
  rev -= rint(rev);
  const float f = (float)rev;
  float2 o;
  o.x = __builtin_amdgcn_cosf(f);
  o.y = __builtin_amdgcn_sinf(f);
  return o;
}

#define G_WS (wsp())
#define G_XF (outp())
#define G_XB ((bf16_t*)(wsp() + OFF_XB))
#define G_ZB ((bf16_t*)(wsp() + OFF_Z))
#define G_OB ((bf16_t*)(wsp() + OFF_O))
#define G_QC ((bf16_t*)(wsp() + OFF_QC))
#define G_KVC ((bf16_t*)(wsp() + OFF_KVC))
#define G_MEMB ((bf16_t*)(wsp() + OFF_MEMB))
#define G_MEMKV ((bf16_t*)(wsp() + OFF_MEMKV))
#define G_XQ ((bf16_t*)(wsp() + OFF_Z))
#define G_XO ((bf16_t*)(wsp() + OFF_Z) + (size_t)NTOK * 512)
#define G_ACT ((bf16_t*)(wsp() + OFF_Z))
#define G_SS ((float*)(wsp() + OFF_SS))
#define G_SSMEM ((float*)(wsp() + OFF_SSMEM))
#define G_SSCQ ((float*)(wsp() + OFF_SSCQ))
#define G_SSCKV ((float*)(wsp() + OFF_SSCKV))
#define G_CS1 ((float2*)(wsp() + OFF_CS1))
#define G_CS2 ((float2*)(wsp() + OFF_CS2))
#define G_CSC ((float2*)(wsp() + OFF_CSC))
__global__ void __launch_bounds__(512, 2) mega(Params p) {
  cg::grid_group grid = cg::this_grid();
  const int nb = gridDim.x, bid = blockIdx.x, t = threadIdx.x;
  if (wsp() == nullptr) grid.sync();
  volatile LAS unsigned* xst = (volatile LAS unsigned*)(smem + SMEM_MAIN);
  if (t < 4) xst[t] = 0u;
  __syncthreads();
  const XcdBarrier xbar = xcd_barrier_post((unsigned*)(G_WS + OFF_BAR), xst);
  row_prep(inp(0), nullptr, G_XB, G_SS, 16, NTOK, true);
  row_prep(inp(1), nullptr, G_MEMB, G_SSMEM, 1, 2048, false);
  for (int idx = bid * NT + tid_opaque(); idx < 163840; idx += nb * NT) {
    if (idx < 65536) {
      const int pos = idx >> 5, i = idx & 31;
      G_CS1[idx] = cossin((double)pos * dpow(0.7498942093324559, i));
    } else if (idx < 131072) {
      const int e = idx - 65536;
      const int pos = e >> 5, i = e & 31;
      const double a = (i < 16) ? (double)(pos >> 6) * dpow(0.5623413251903491, i) : (double)(pos & 63) * dpow(0.5623413251903491, i - 16);
      G_CS2[e] = cossin(a);
    } else {
      const int e = idx - 131072;
      const int pos = e >> 4, i = e & 15;
      G_CSC[e] = cossin((double)pos * dpow(0.5623413251903491, i));
    }
  }
  convert_layer(0, bid, nb);
  GSYNC();

  for (int L = 0; L < 4; ++L) {
    const int j = L >> 1;
    const bool odd = (L & 1) != 0;
    const bf16_t* wb = (const bf16_t*)(G_WS + OFF_W) + (size_t)(L & 1) * WSZ;
    Ep e{};
    e.cs1 = G_CS1; e.cs2 = G_CS2; e.csc = G_CSC;

    {
      const int nin = (odd ? 8 : 6) * 64;
      for (int rp = 0; rp < REP_P1; ++rp)
      for (int item = bid; item < nin; item += nb) {
        const int nt = item >> 6, mt = item & 63;
        e.ss = G_SS; e.nss = 16; e.inv_n = 1.f / 1024.f; e.out = G_ZB; e.ldo = ZLD;
        if (!odd) {
          e.g_a = inp(4) + j * 64; e.g_b = inp(5) + j * 64;
          gemm_tile<EPI_IN_AB, 256, true>(G_XB, DM, wb + W_IN, DM, mt * 256, nt * 256, e);
        } else {
          e.ss_cq = G_SSCQ; e.ss_ckv = G_SSCKV;
          gemm_tile<EPI_IN_CD, 256, true>(G_XB, DM, wb + W_IN, DM, mt * 256, nt * 256, e);
        }
      }
      const bool memkv_in_p1 = !odd && nb == 256;
      if (memkv_in_p1) {
        if (bid >= 224) {
          const int it = bid - 224;
          const int nt = it >> 3, mt = it & 7;
          e.ss = G_SSMEM; e.nss = 1; e.inv_n = 1.f / 1024.f; e.out = G_MEMKV; e.ldo = 1024;
          gemm_tile<EPI_PLAIN, 256, false>(G_MEMB, DM, wb + W_XKV, DM, mt * 256, nt * 256, e);
        } else if (bid >= 128 && L < 3) convert_layer(L + 1, bid - 128, 96);
      } else if (L < 3) { if (odd || nb < 256) convert_layer(L + 1, bid, nb); else if (bid >= 128) convert_layer(L + 1, bid - 128, nb - 128); }
    }
    GSYNC();
    if (odd) {
      const int total = 3 * 64 + 8 * 64;
      for (int rp = 0; rp < REP_P1; ++rp)
      for (int item = bid; item < total; item += nb) {
        if (item < 192) {
          const int nt = item >> 6, mt = item & 63;
          e.ss = G_SSCQ; e.nss = 4; e.inv_n = 1.f / 256.f; e.out = G_QC; e.ldo = 768;
          gemm_tile<EPI_UQ, 256, false>(G_ZB, ZLD, wb + W_UQ, 256, mt * 256, nt * 256, e);
        } else {
          const int it = item - 192;
          const int nt = it >> 6, mt = it & 63;
          e.ss = G_SSCKV; e.nss = 2; e.inv_n = 1.f / 128.f; e.out = G_KVC; e.ldo = 1024;
          gemm_tile<EPI_PLAIN, 128, false>(G_ZB + 256, ZLD, wb + W_UKV, 128, mt * 256, nt * 128, e);
        }
      }
      GSYNC();
    }
    for (int rp = 0; rp < REP_P2; ++rp)
    for (int item = bid; item < 512; item += nb) {
      const int idx = item & 255;
      const int pl = idx & 7, rest = idx >> 3;
      AttArgs a{};
      int Lp2 = L; asm volatile("" : "+s"(Lp2));
      if (!(Lp2 & 1)) {
        const int qg = rest & 15, pg = rest >> 4;
        const int pair = pg * 8 + pl;
        const int b = pair >> 1, kvh = pair & 1;
        const int qt = qg >> 2, g = qg & 3;
        const int head = kvh * 4 + g;
        const bf16_t* zrow = G_ZB + (size_t)b * SEQ * ZLD;
        a.ldq = a.ldk = a.ldv = ZLD; a.ldo = DM;
        a.scale = 0.125f;
        const int q0 = qt * 512;
        if (item < 256) {
          a.q = zrow + head * 64; a.k = zrow + 512 + kvh * 64; a.v = zrow + 640 + kvh * 64;
          a.o = G_OB + (size_t)b * SEQ * DM + head * 64;
          attn_item<64, 64, 0, 2>(a, q0, 0, 32);
        } else {
          const int qtb = rest & 15, pgb = rest >> 4;
          const int pairb = pgb * 8 + pl;
          const int bb = pairb >> 1, kvb = pairb & 1;
          const bf16_t* zrb = G_ZB + (size_t)bb * SEQ * ZLD;
          a.q = zrb + 768 + kvb * 256; a.k = zrb + 1280 + kvb * 64; a.v = zrb + 1408 + kvb * 64;
          a.o = G_OB + (size_t)bb * SEQ * DM + 512 + kvb * 256;
          a.sinkp = inp(6) + j * 8 + kvb * 4;
          const int q0b = qtb * 128;
          const int tlo = max(q0b - 128, 0) >> 6, thi = min(q0b + 128 + 128, SEQ) >> 6;
          attn_item<64, 64, 1, 2, true>(a, q0b, tlo, thi);
        }
      } else {
        const int qt = rest & 3, pg = rest >> 2;
        const int pair = pg * 8 + pl;
        const int b = pair >> 3, hd = pair & 7;
        const int q0 = qt * 512;
        const bf16_t* zrow = G_ZB + (size_t)b * SEQ * ZLD;
        if (item < 256) {
          a.q = G_QC + (size_t)b * SEQ * 768 + hd * 96; a.ldq = 768;
          a.k = G_KVC + (size_t)b * SEQ * 1024 + hd * 128; a.ldk = 1024;
          a.k2 = zrow + 384; a.ldk2 = ZLD;
          a.v = G_KVC + (size_t)b * SEQ * 1024 + hd * 128 + 64; a.ldv = 1024;
          a.o = G_OB + (size_t)b * SEQ * DM + hd * 64; a.ldo = DM;
          a.scale = 0.10206207261596577f;
          attn_item<96, 64, 3, 2>(a, q0, 0, 32);
        } else {
          a.q = zrow + 512 + hd * 64; a.k = zrow + 1024 + hd * 64; a.v = zrow + 1536 + hd * 64;
          a.ldq = a.ldk = a.ldv = ZLD;
          a.o = G_OB + (size_t)b * SEQ * DM + 512 + hd * 64; a.ldo = DM;
          a.scale = 0.125f;
          a.rpb = inp(13) + (size_t)(j * 8 + hd) * 465;
          const int ra = q0 >> 6;
          const int tlo = min(max(ra - 4, 0), 24), thi = min(max(ra + 7 - 4, 0), 24) + 8;
          attn_item<64, 64, 2, 2>(a, q0, tlo, thi);
        }
      }
    }
    GSYNC();
    for (int item = bid; item < 4 * 64; item += nb) {
      const int nt = item >> 6, mt = item & 63;
      e.ss = nullptr; e.xf = G_XF; e.xb = G_XB; e.ss_out = G_SS;
      gemm_tile<EPI_RESID, 256, false>(G_OB, DM, wb + W_OUT, DM, mt * 256, nt * 256, e);
    }
    GSYNC();
    for (int rp = 0; rp < REP_P4; ++rp)
    if (!odd && nb == 256) {
      for (int item = bid; item < 4 * 64; item += nb) {
        const int nt = item >> 6, mt = item & 63;
        e.ss = G_SS; e.nss = 16; e.inv_n = 1.f / 1024.f; e.out = G_XQ; e.ldo = 512;
        gemm_tile<EPI_PLAIN, 128, true>(G_XB, DM, wb + W_XQ, DM, mt * 256, nt * 128, e);
      }
    } else
    for (int item = bid; item < 2 * 64 + 4 * 8; item += nb) {
      if (item < 128) {
        const int nt = item >> 6, mt = item & 63;
        e.ss = G_SS; e.nss = 16; e.inv_n = 1.f / 1024.f; e.out = G_XQ; e.ldo = 512;
        gemm_tile<EPI_PLAIN, 256, true>(G_XB, DM, wb + W_XQ, DM, mt * 256, nt * 256, e);
      } else {
        const int it = item - 128;
        const int nt = it >> 3, mt = it & 7;
        e.ss = G_SSMEM; e.nss = 1; e.inv_n = 1.f / 1024.f; e.out = G_MEMKV; e.ldo = 1024;
        gemm_tile<EPI_PLAIN, 256, false>(G_MEMB, DM, wb + W_XKV, DM, mt * 256, nt * 256, e);
      }
    }
    GSYNC();
    for (int rp = 0; rp < REP_P4; ++rp)
    for (int item = bid; item < 256; item += nb) {
      const int pl = item & 7, rest = item >> 3;
      const int qt = rest & 7, pg = rest >> 3;
      const int pair = pg * 8 + pl;
      const int b = pair >> 2, hd = pair & 3;
      AttArgs a{};
      a.q = G_XQ + (size_t)b * SEQ * 512 + hd * 128; a.ldq = 512;
      a.k = G_MEMKV + (size_t)b * 256 * 1024 + hd * 128; a.ldk = 1024;
      a.v = G_MEMKV + (size_t)b * 256 * 1024 + 512 + hd * 128; a.ldv = 1024;
      a.o = G_XO + (size_t)b * SEQ * 512 + hd * 128; a.ldo = 512;
      a.scale = 0.08838834764831845f;
      attn_item<128, 128, 0, 1>(a, qt * 256, 0, 4);
    }
    GSYNC();
    for (int item = bid; item < 4 * 64; item += nb) {
      const int nt = item >> 6, mt = item & 63;
      e.ss = nullptr; e.xf = G_XF; e.xb = G_XB; e.ss_out = G_SS;
      gemm_tile<EPI_RESID, 256, false>(G_XO, 512, wb + W_XO, 512, mt * 256, nt * 256, e);
    }
    GSYNC();
    bool pre7 = false;
    for (int rp = 0; rp < REP_P7; ++rp)
    for (int item = bid; item < 20 * 64 + 4 * 64; item += nb) {
      e.ss = G_SS; e.nss = 16; e.inv_n = 1.f / 1024.f; e.out = G_ACT; e.ldo = 2816;
      if (item < 1280) {
        const int nt = item >> 6, mt = item & 63;
        const int nxt = item + nb;
        const bool chain = nxt < 1280;
        gemm_tile256<EPI_GU, true>(G_XB, DM, wb + W_GU, DM, mt * 256, nt * 256, e, pre7, chain ? (nxt & 63) * 256 : -1, (nxt >> 6) * 256);
        pre7 = chain;
      } else {
        const int it = item - 1280;
        const int nt = it >> 6, mt = it & 63;
        gemm_tile<EPI_GU, 128, true>(G_XB, DM, wb + W_GU, DM, mt * 256, 5120 + nt * 128, e);
      }
    }
    GSYNC();
    for (int item = bid; item < 4 * 64; item += nb) {
      const int nt = item >> 6, mt = item & 63;
      e.ss = nullptr; e.xf = G_XF; e.xb = G_XB; e.ss_out = G_SS;
      gemm_tile<EPI_RESID, 256, false>(G_ACT, 2816, wb + W_DOWN, 2816, mt * 256, nt * 256, e);
    }
    GSYNC();
  }
  {
    const int t2 = tid_opaque();
    const int w = t2 >> 6, l = t2 & 63;
    const float4* gf = (const float4*)inp(23);
    for (int row = bid * 8 + w; row < NTOK; row += nb * 8) {
      const uint2* xp = (const uint2*)(G_XB + (size_t)row * DM);
      float4* op = (float4*)(G_XF + (size_t)row * DM);
      float4 v[4];
      float s2 = 0.f;
#pragma unroll
      for (int i = 0; i < 4; ++i) {
        const uint2 u = xp[l + 64 * i];
        v[i].x = h_lo(u.x); v[i].y = h_hi(u.x);
        v[i].z = h_lo(u.y); v[i].w = h_hi(u.y);
        s2 += v[i].x * v[i].x + v[i].y * v[i].y + v[i].z * v[i].z + v[i].w * v[i].w;
      }
#pragma unroll
      for (int o = 32; o; o >>= 1) s2 += __shfl_xor(s2, o);
      const float rr = rsqrtf(s2 * (1.f / 1024.f) + EPS);
#pragma unroll
      for (int i = 0; i < 4; ++i) {
        const float4 g = gf[l + 64 * i];
        float4 o4 = {v[i].x * rr * g.x, v[i].y * rr * g.y, v[i].z * rr * g.z, v[i].w * rr * g.w};
        op[l + 64 * i] = o4;
      }
    }
  }
}
#undef G_WS
#undef G_XF
#undef G_XB
#undef G_ZB
#undef G_OB
#undef G_QC
#undef G_KVC
#undef G_MEMB
#undef G_MEMKV
#undef G_XQ
#undef G_XO
#undef G_ACT
#undef G_SS
#undef G_SSMEM
#undef G_SSCQ
#undef G_SSCKV
#undef G_CS1
#undef G_CS2
#undef G_CSC
extern "C" void kernel_launch(void* const* d_in, const int* in_sizes, int n_in, void* d_out, int out_size, void* d_ws, size_t ws_size, hipStream_t stream) {
  static int grid_blocks = 0;
  if (!grid_blocks) {
    int dev = 0, cus = 0, per_cu = 0;
    hipGetDevice(&dev);
    hipDeviceGetAttribute(&cus, hipDeviceAttributeMultiprocessorCount, dev);
    hipOccupancyMaxActiveBlocksPerMultiprocessor(&per_cu, mega, NT, 0);
    if (per_cu > 1) per_cu = 1;
    if (per_cu < 1) per_cu = 1;
    grid_blocks = cus * per_cu;
  }
  Params p{};
  for (int i = 0; i < 24; ++i) p.in[i] = (const float*)d_in[i];
  p.out = (float*)d_out;
  p.ws = (unsigned char*)d_ws;
  void* args[] = {&p};
  hipMemsetAsync((unsigned char*)d_ws + OFF_BAR, 0, XCD_BAR_WORDS * sizeof(unsigned), stream);
  hipError_t e = hipLaunchCooperativeKernel((void*)mega, dim3(grid_blocks), dim3(NT), args, 0, stream);
  if (e != hipSuccess) fprintf(stderr, "cooperative launch failed: %s (grid %d)\n", hipGetErrorString(e), grid_blocks);
}
```

```cpp
#include <hip/hip_runtime.h>
#include <hip/hip_cooperative_groups.h>
#include <cstdio>
namespace cg = cooperative_groups;

typedef unsigned short bf16_t;
typedef short bf16x8 __attribute__((ext_vector_type(8)));
typedef short s16x4 __attribute__((ext_vector_type(4)));
typedef float f32x16 __attribute__((ext_vector_type(16)));
typedef float f32x4 __attribute__((ext_vector_type(4)));
typedef float f32x2 __attribute__((ext_vector_type(2)));
typedef __bf16 bf2_t __attribute__((ext_vector_type(2)));
typedef unsigned u32x4 __attribute__((ext_vector_type(4)));
typedef unsigned u32x2 __attribute__((ext_vector_type(2)));

#define DI __device__ __forceinline__
#define MFMA32(a, b, c) __builtin_amdgcn_mfma_f32_32x32x16_bf16((a), (b), (c), 0, 0, 0)

constexpr int NTOK = 16384;
constexpr int SEQ = 2048;
constexpr int DM = 1024;
constexpr int ZLD = 2048;
constexpr float EPS = 1e-6f;
constexpr float LOG2E = 1.4426950408889634f;
constexpr int NT = 512;
constexpr int SMEM_MAIN = 135168;
constexpr int SMEM_RSTD = SMEM_MAIN + 16;
constexpr int SMEM_BYTES = SMEM_MAIN + 16 + 1024;
#ifndef REP_SYNC
#define REP_SYNC 1
#endif
#define GSYNC() do { for (int _r = 0; _r < REP_SYNC; ++_r) xcd_barrier(xbar); } while (0)
#ifndef REP_P1
#define REP_P1 1
#endif
#ifndef REP_P4
#define REP_P4 1
#endif
#ifndef REP_P7
#define REP_P7 1
#endif
#ifndef REP_P2
#define REP_P2 1
#endif

constexpr size_t OFF_XB = 0;
constexpr size_t OFF_Z = 33554432;
constexpr size_t OFF_O = 100663296;
constexpr size_t OFF_QC = 134217728;
constexpr size_t OFF_KVC = 159383552;
constexpr size_t OFF_MEMB = 192937984;
constexpr size_t OFF_MEMKV = 197132288;
constexpr size_t OFF_W = 201326592;
constexpr size_t OFF_SS = 258211840;
constexpr size_t OFF_SSMEM = 259260416;
constexpr size_t OFF_SSCQ = 259268608;
constexpr size_t OFF_SSCKV = 259530752;
constexpr size_t OFF_CS1 = 259661824;
constexpr size_t OFF_CS2 = 260186112;
constexpr size_t OFF_CSC = 260710400;
constexpr size_t OFF_BAR = 260972544;
constexpr size_t W_IN = 0, W_UQ = 2097152, W_UKV = 2293760, W_OUT = 2424832, W_XQ = 3473408, W_XKV = 3997696,
                 W_XO = 5046272, W_GU = 5570560, W_DOWN = 11337728, WSZ = 14221312;

struct Params {
  const float* in[24];
  float* out;
  unsigned char* ws;
};

__shared__ __attribute__((aligned(16))) unsigned char smem[SMEM_BYTES];

DI unsigned pack2(float a, float b) {
  f32x2 v = {a, b};
  bf2_t r = __builtin_convertvector(v, bf2_t);
  return __builtin_bit_cast(unsigned, r);
}
typedef _Float16 h2_t __attribute__((ext_vector_type(2)));
typedef _Float16 h8_t __attribute__((ext_vector_type(8)));
DI unsigned pack2h(float a, float b) {
  f32x2 v = {a, b};
  h2_t r = __builtin_convertvector(v, h2_t);
  return __builtin_bit_cast(unsigned, r);
}
DI float h_lo(unsigned u) { return (float)__builtin_bit_cast(h2_t, u)[0]; }
DI float h_hi(unsigned u) { return (float)__builtin_bit_cast(h2_t, u)[1]; }
DI int crow(int i, int h) { return (i & 3) + 8 * (i >> 2) + 4 * h; }
typedef const float* cfp_t;
DI cfp_t inp(int i) {
  asm volatile("" : "+s"(i));
  return ((const __attribute__((address_space(4))) cfp_t*)__builtin_amdgcn_kernarg_segment_ptr())[i];
}
DI unsigned char* wsp() { return (unsigned char*)inp(25); }
DI float* outp() { return (float*)inp(24); }
DI int tid_opaque() { int t = threadIdx.x; asm volatile("" : "+v"(t)); return t; }
DI float fexp2(float x) { return __builtin_amdgcn_exp2f(x); }


#define XB_TMO      128
#define XB_XCNT(j)  (256  + 64 * (j))
#define XB_XSUB(j)  (1280 + 64 * (j))
#define XB_XGEN(j)  (2304 + 64 * (j))
#define XB_TOP      3328
#define XB_TOPGEN   3392
#define XCD_BAR_WORDS 3456
#define XB_SPIN_CAP (1u << 20)
#define LAS __attribute__((address_space(3)))
DI unsigned xb_ld(unsigned* p) { return __hip_atomic_load(p, __ATOMIC_RELAXED, __HIP_MEMORY_SCOPE_AGENT); }
DI unsigned xb_add(unsigned* p, unsigned v) { return __hip_atomic_fetch_add(p, v, __ATOMIC_RELAXED, __HIP_MEMORY_SCOPE_AGENT); }
DI unsigned xb_xcc_id() { return (unsigned)__builtin_amdgcn_s_getreg((3 << 11) | 20) & 0xFu; }
#define XB_SPIN(cond, bar) do { unsigned _sp = 0; while (cond) { __builtin_amdgcn_s_sleep(0); \
    if ((++_sp & 255u) == 0u) { if (xb_ld(&(bar)[XB_TMO])) break; if (_sp > XB_SPIN_CAP) { atomicAdd(&(bar)[XB_TMO], 1u); break; } } } } while (0)
struct XcdBarrier { unsigned* bar; unsigned x; volatile LAS unsigned* st; };
DI XcdBarrier xcd_barrier_post(unsigned* bar, volatile LAS unsigned* st) {
  XcdBarrier b; b.bar = bar; b.x = xb_xcc_id(); b.st = st;
  if (threadIdx.x == 0) (void)xb_add(&bar[XB_XCNT(b.x)], 1u);
  return b;
}
DI void xcd_barrier_complete(unsigned* bar, unsigned x, unsigned& nloc, unsigned& nx) {
  const unsigned G = gridDim.x * gridDim.y * gridDim.z;
  unsigned sum, cnt, mine, sp = 0u;
  for (;;) {
    sum = 0u; cnt = 0u; mine = 0u;
#pragma unroll
    for (unsigned j = 0; j < 16; ++j) { const unsigned c = xb_ld(&bar[XB_XCNT(j)]); sum += c; cnt += (c > 0u) ? 1u : 0u; mine = (j == x) ? c : mine; }
    if (sum == G) break;
    __builtin_amdgcn_s_sleep(1);
    if ((++sp & 255u) == 0u) { if (xb_ld(&bar[XB_TMO])) break; if (sp > XB_SPIN_CAP) { atomicAdd(&bar[XB_TMO], 1u); break; } }
  }
  nloc = mine > 0u ? mine : 1u; nx = cnt > 0u ? cnt : 1u;
}
DI void xcd_barrier(const XcdBarrier& b) {
  asm volatile("s_waitcnt vmcnt(0)" ::: "memory");
  __syncthreads();
  if (threadIdx.x == 0) {
    unsigned* bar = b.bar;
    __builtin_amdgcn_s_waitcnt(0);
    unsigned nloc = b.st[0], nx = b.st[1];
    if (nloc == 0u) { xcd_barrier_complete(bar, b.x, nloc, nx); b.st[0] = nloc; b.st[1] = nx; }
    const unsigned old = xb_add(&bar[XB_XSUB(b.x)], 1u);
    const unsigned gen = old / nloc;
    if (old + 1u == (gen + 1u) * nloc) {
      __builtin_amdgcn_fence(__ATOMIC_RELEASE, "agent");
      asm volatile("s_waitcnt vmcnt(0)" ::: "memory");
      const unsigned og = xb_add(&bar[XB_TOP], 1u);
      const unsigned tg = og / nx;
      if (og + 1u == (tg + 1u) * nx) xb_add(&bar[XB_TOPGEN], 1u);
      else XB_SPIN(xb_ld(&bar[XB_TOPGEN]) == tg, bar);
      __builtin_amdgcn_fence(__ATOMIC_ACQUIRE, "agent");
      xb_add(&bar[XB_XGEN(b.x)], 1u);
      asm volatile("s_waitcnt vmcnt(0)" ::: "memory");
    } else {
      XB_SPIN(xb_ld(&bar[XB_XGEN(b.x)]) == gen, bar);
      __builtin_amdgcn_fence(__ATOMIC_ACQUIRE, "agent");
      asm volatile("s_waitcnt vmcnt(0)" ::: "memory");
    }
  }
  __syncthreads();
}

enum { EPI_PLAIN = 0, EPI_IN_AB = 1, EPI_IN_CD = 2, EPI_UQ = 3, EPI_RESID = 4, EPI_GU = 5 };

struct Ep {
  const float* ss;
  int nss;
  float inv_n;
  bf16_t* out;
  int ldo;
  float* xf;
  bf16_t* xb;
  float* ss_out;
  float* ss_cq;
  float* ss_ckv;
  const float* g_a;
  const float* g_b;
  const float2* cs1;
  const float2* cs2;
  const float2* csc;
};

DI void chunk_pair(const float* tr, bf16_t* dst, int A, int B, float sa, const float* g, const float2* cs, bool) {
  float4 a0 = *(const float4*)(tr + A), a1 = *(const float4*)(tr + A + 4);
  float4 b0 = *(const float4*)(tr + B), b1 = *(const float4*)(tr + B + 4);
  float a[8] = {a0.x * sa, a0.y * sa, a0.z * sa, a0.w * sa, a1.x * sa, a1.y * sa, a1.z * sa, a1.w * sa};
  float b[8] = {b0.x * sa, b0.y * sa, b0.z * sa, b0.w * sa, b1.x * sa, b1.y * sa, b1.z * sa, b1.w * sa};
  if (g) {
#pragma unroll
    for (int k = 0; k < 8; ++k) { a[k] *= g[A + k]; b[k] *= g[B + k]; }
  }
  if (cs) {
#pragma unroll
    for (int k = 0; k < 8; ++k) {
      const float2 c = cs[k];
      const float x1 = a[k], x2 = b[k];
      a[k] = x1 * c.x - x2 * c.y;
      b[k] = x1 * c.y + x2 * c.x;
    }
  }
  uint4 ua, ub;
  ua.x = pack2(a[0], a[1]); ua.y = pack2(a[2], a[3]); ua.z = pack2(a[4], a[5]); ua.w = pack2(a[6], a[7]);
  ub.x = pack2(b[0], b[1]); ub.y = pack2(b[2], b[3]); ub.z = pack2(b[4], b[5]); ub.w = pack2(b[6], b[7]);
  *(uint4*)(dst + A) = ua;
  *(uint4*)(dst + B) = ub;
}

template <int EPI>
DI void gemm_epilogue(const Ep& e, int m0, int n0) {
  const int t = tid_opaque();
  const float* rstdL = (const float*)(smem + SMEM_RSTD);
  const float* T = (const float*)smem;
  if constexpr (EPI == EPI_PLAIN) {
#pragma unroll
    for (int p = 0; p < 8; ++p) {
      const int row = p * 32 + (t >> 4), c8 = (t & 15) * 8;
      const float rstd = rstdL[row];
      const float4 a = *(const float4*)(T + row * 132 + c8), b = *(const float4*)(T + row * 132 + c8 + 4);
      uint4 u;
      u.x = pack2(a.x * rstd, a.y * rstd); u.y = pack2(a.z * rstd, a.w * rstd);
      u.z = pack2(b.x * rstd, b.y * rstd); u.w = pack2(b.z * rstd, b.w * rstd);
      *(uint4*)(e.out + (size_t)(m0 + row) * e.ldo + n0 + c8) = u;
    }
    return;
  } else if constexpr (EPI == EPI_RESID) {
#pragma unroll
    for (int p = 0; p < 8; ++p) {
      const int row = p * 32 + (t >> 4), c8 = (t & 15) * 8;
      const float4 a = *(const float4*)(T + row * 132 + c8), b = *(const float4*)(T + row * 132 + c8 + 4);
      bf16_t* bp = e.xb + (size_t)(m0 + row) * DM + n0 + c8;
      const uint4 xo4 = *(const uint4*)bp;
      uint4 u;
      u.x = pack2h(h_lo(xo4.x) + a.x, h_hi(xo4.x) + a.y); u.y = pack2h(h_lo(xo4.y) + a.z, h_hi(xo4.y) + a.w);
      u.z = pack2h(h_lo(xo4.z) + b.x, h_hi(xo4.z) + b.y); u.w = pack2h(h_lo(xo4.w) + b.z, h_hi(xo4.w) + b.w);
      *(uint4*)bp = u;
      const float r0 = h_lo(u.x), r1 = h_hi(u.x), r2 = h_lo(u.y), r3 = h_hi(u.y);
      const float r4 = h_lo(u.z), r5 = h_hi(u.z), r6 = h_lo(u.w), r7 = h_hi(u.w);
      float s2 = r0 * r0 + r1 * r1 + r2 * r2 + r3 * r3 + r4 * r4 + r5 * r5 + r6 * r6 + r7 * r7;
      s2 += __shfl_xor(s2, 1); s2 += __shfl_xor(s2, 2); s2 += __shfl_xor(s2, 4);
      if ((t & 7) == 0) e.ss_out[(size_t)(m0 + row) * 16 + ((n0 + c8) >> 6)] = s2;
    }
    return;
  } else if constexpr (EPI == EPI_GU) {
#pragma unroll
    for (int p = 0; p < 4; ++p) {
      const int row = p * 64 + (t >> 3), o8 = (t & 7) * 8;
      const int gc = (o8 >> 5) * 64 + (o8 & 31);
      const float rstd = rstdL[row];
      const float4 g0 = *(const float4*)(T + row * 132 + gc), g1 = *(const float4*)(T + row * 132 + gc + 4);
      const float4 u0 = *(const float4*)(T + row * 132 + gc + 32), u1 = *(const float4*)(T + row * 132 + gc + 36);
      const float gg[8] = {g0.x, g0.y, g0.z, g0.w, g1.x, g1.y, g1.z, g1.w};
      const float uu[8] = {u0.x, u0.y, u0.z, u0.w, u1.x, u1.y, u1.z, u1.w};
      float r[8];
#pragma unroll
      for (int k = 0; k < 8; ++k) {
        const float g = gg[k] * rstd, u = uu[k] * rstd;
        r[k] = g * __builtin_amdgcn_rcpf(1.f + fexp2(-g * LOG2E)) * u;
      }
      uint4 o;
      o.x = pack2(r[0], r[1]); o.y = pack2(r[2], r[3]); o.z = pack2(r[4], r[5]); o.w = pack2(r[6], r[7]);
      *(uint4*)(e.out + (size_t)(m0 + row) * e.ldo + (n0 >> 1) + o8) = o;
    }
    return;
  }
  const int row = t >> 1, c0 = (t & 1) * 64;
  const int gr = m0 + row;
  const int n = n0 + c0;
  const float* tr = T + row * 132 + c0;
  const float rstd = rstdL[row];
  if constexpr (EPI == EPI_IN_AB || EPI == EPI_IN_CD || EPI == EPI_UQ) {
    bf16_t* dst = e.out + (size_t)gr * e.ldo + n;
    const int pos = gr & (SEQ - 1);
    if constexpr (EPI == EPI_IN_AB) {
      float sa = rstd;
      const float* g = nullptr;
      const float2* cs = nullptr;
      if (n < 640) {
        float s2 = 0.f;
#pragma unroll
        for (int c = 0; c < 16; ++c) {
          float4 a = *(const float4*)(tr + 4 * c);
          s2 += a.x * a.x + a.y * a.y + a.z * a.z + a.w * a.w;
        }
        s2 *= rstd * rstd;
        sa = rstd * rsqrtf(s2 * (1.f / 64.f) + EPS);
        g = (n < 512) ? e.g_a : e.g_b;
        cs = e.cs2 + pos * 32;
      } else if (n >= 768 && n < 1408) {
        cs = e.cs1 + pos * 32;
      }
#pragma unroll
      for (int c = 0; c < 4; ++c) chunk_pair(tr, dst, 8 * c, 32 + 8 * c, sa, g, cs ? cs + 8 * c : nullptr, false);
    } else if constexpr (EPI == EPI_IN_CD) {
      const float2* cs = nullptr;
      bool zb = false;
      if (n < 384) {
        float s2 = 0.f;
#pragma unroll
        for (int c = 0; c < 16; ++c) {
          float4 a = *(const float4*)(tr + 4 * c);
          s2 += a.x * a.x + a.y * a.y + a.z * a.z + a.w * a.w;
        }
        if (n < 256) e.ss_cq[(size_t)gr * 4 + (n >> 6)] = s2 * rstd * rstd;
        else e.ss_ckv[(size_t)gr * 2 + ((n - 256) >> 6)] = s2 * rstd * rstd;
      } else if (n == 384) {
        cs = e.csc + pos * 16;
        zb = true;
      }
      chunk_pair(tr, dst, 0, 16, rstd, nullptr, cs, false);
      chunk_pair(tr, dst, 8, 24, rstd, nullptr, cs ? cs + 8 : nullptr, false);
      chunk_pair(tr, dst, 32, 48, zb ? 0.f : rstd, nullptr, nullptr, false);
      chunk_pair(tr, dst, 40, 56, zb ? 0.f : rstd, nullptr, nullptr, false);
    } else if constexpr (EPI == EPI_UQ) {
      const float2* csr = e.csc + pos * 16;
      const float2* cs_a = (n >= 64 && ((n - 64) % 96) == 0) ? csr : nullptr;
      const float2* cs_b = (((n + 32 - 64) % 96) == 0) ? csr : nullptr;
      chunk_pair(tr, dst, 0, 16, rstd, nullptr, cs_a, false);
      chunk_pair(tr, dst, 8, 24, rstd, nullptr, cs_a ? cs_a + 8 : nullptr, false);
      chunk_pair(tr, dst, 32, 48, rstd, nullptr, cs_b, false);
      chunk_pair(tr, dst, 40, 56, rstd, nullptr, cs_b ? cs_b + 8 : nullptr, false);
    }
  }
}

DI int lds_byte8(int r, int c) {
  const int st = (r >> 4) * 2 + (c >> 5), rr = r & 15, cc = c & 31, ob = rr * 64 + cc * 2;
  return st * 1024 + (ob ^ (((ob >> 9) & 1) << 5));
}
DI void stage_rc8(int b, int& R, int& C) {
  const int st = b / 1024, sb = b % 1024, swz = sb ^ (((sb >> 9) & 1) << 5);
  R = (st >> 1) * 16 + swz / 64; C = (st & 1) * 32 + (swz % 64) / 2;
}
template <int EPI, bool F16>
DI void gemm_tile256(const bf16_t* __restrict__ A, int lda, const bf16_t* __restrict__ Bt, int K, int m0, int n0, const Ep& e,
                     bool pre = false, int nm0 = -1, int nn0 = 0) {
  constexpr int HT = 128 * 64;
  bf16_t* shm = (bf16_t*)smem;
  const int t = tid_opaque();
#define SA8(b, h) (shm + ((b) * 2 + (h)) * HT)
#define SB8(b, h) (shm + (4 + (b) * 2 + (h)) * HT)
#define STAGE8(P, BASE, LD, br, kt) do { const long _g = (long)(br) * (LD) + (long)(kt) * 64;              \
    _Pragma("unroll") for (int _i = 0; _i < 2; ++_i) { const int _b = t * 16 + _i * 8192; int _r, _c; stage_rc8(_b, _r, _c); \
      __builtin_amdgcn_global_load_lds((const unsigned*)((BASE) + _g + (long)_r * (LD) + _c),              \
                                       (unsigned*)((char*)(P) + _b), 16, 0, 0); } } while (0)
#define LDA8(dst, b, h) _Pragma("unroll") for (int m = 0; m < 4; ++m) _Pragma("unroll") for (int k = 0; k < 2; ++k) \
    dst[m][k] = *(const bf16x8*)((const char*)SA8(b, h) + lds_byte8(wr * 64 + m * 16 + fr, k * 32 + fq * 8))
#define LDB8(dst, b, h) _Pragma("unroll") for (int n = 0; n < 2; ++n) _Pragma("unroll") for (int k = 0; k < 2; ++k) \
    dst[n][k] = *(const bf16x8*)((const char*)SB8(b, h) + lds_byte8(wc * 32 + n * 16 + fr, k * 32 + fq * 8))
#define MF8(a, b, c) (F16 ? __builtin_amdgcn_mfma_f32_16x16x32_f16(__builtin_bit_cast(h8_t, a), __builtin_bit_cast(h8_t, b), c, 0, 0, 0) \
                          : __builtin_amdgcn_mfma_f32_16x16x32_bf16(a, b, c, 0, 0, 0))
#define MMA8(ai, bj, AT, BT) do { __builtin_amdgcn_s_setprio(1);                                           \
    _Pragma("unroll") for (int m = 0; m < 4; ++m) _Pragma("unroll") for (int n = 0; n < 2; ++n) _Pragma("unroll") for (int k = 0; k < 2; ++k) \
      acc[ai][bj][m][n] = MF8(AT[m][k], BT[n][k], acc[ai][bj][m][n]);                                      \
    __builtin_amdgcn_s_setprio(0); } while (0)
#define WAIT_V8(n) asm volatile("s_waitcnt vmcnt(" #n ")" ::: "memory")
#define WAIT_L8(n) asm volatile("s_waitcnt lgkmcnt(" #n ")" ::: "memory")
#define BAR8 __builtin_amdgcn_s_barrier()
#define SCHED8 __builtin_amdgcn_sched_barrier(0)
  const int brow = m0, bcol = n0;
  const int wid = t >> 6, lane = t & 63, wr = wid >> 2, wc = wid & 3, fr = lane & 15, fq = lane >> 4;
  f32x4 acc[2][2][4][2];
  {
    float zinit = 0.f;
    asm volatile("" : "+v"(zinit));
#pragma unroll
    for (int a = 0; a < 2; ++a)
#pragma unroll
      for (int b = 0; b < 2; ++b)
#pragma unroll
        for (int m = 0; m < 4; ++m)
#pragma unroll
          for (int n = 0; n < 2; ++n)
#pragma unroll
            for (int j = 0; j < 4; ++j) acc[a][b][m][n][j] = zinit;
  }
  bf16x8 At[4][2], B0[2][2], B1[2][2];
  const int nt = K / 64;
  if (!pre) {
    STAGE8(SB8(0, 0), Bt, K, bcol, 0); STAGE8(SA8(0, 0), A, lda, brow, 0);
    STAGE8(SB8(0, 1), Bt, K, bcol + 128, 0); STAGE8(SA8(0, 1), A, lda, brow + 128, 0);
  }
  if (wr == 1) BAR8;
  WAIT_V8(4); BAR8;
  STAGE8(SB8(1, 0), Bt, K, bcol, 1); STAGE8(SA8(1, 0), A, lda, brow, 1); STAGE8(SB8(1, 1), Bt, K, bcol + 128, 1);
  WAIT_V8(6); BAR8;
  for (int tt = 0; tt < nt - 2; tt += 2) {
    LDB8(B0, 0, 0); SCHED8; LDA8(At, 0, 0); STAGE8(SA8(1, 1), A, lda, brow + 128, tt + 1);
    WAIT_L8(8); BAR8; WAIT_L8(0); MMA8(0, 0, At, B0); BAR8; SCHED8;
    LDB8(B1, 0, 1); STAGE8(SB8(0, 0), Bt, K, bcol, tt + 2);
    BAR8; WAIT_L8(0); MMA8(0, 1, At, B1); BAR8;
    LDA8(At, 0, 1); STAGE8(SA8(0, 0), A, lda, brow, tt + 2);
    BAR8; WAIT_L8(0); MMA8(1, 0, At, B0); BAR8; SCHED8;
    STAGE8(SB8(0, 1), Bt, K, bcol + 128, tt + 2);
    WAIT_V8(6); BAR8; MMA8(1, 1, At, B1); BAR8;
    LDB8(B0, 1, 0); SCHED8; LDA8(At, 1, 0); STAGE8(SA8(0, 1), A, lda, brow + 128, tt + 2);
    WAIT_L8(8); BAR8; WAIT_L8(0); MMA8(0, 0, At, B0); BAR8; SCHED8;
    LDB8(B1, 1, 1); STAGE8(SB8(1, 0), Bt, K, bcol, tt + 3);
    BAR8; WAIT_L8(0); MMA8(0, 1, At, B1); BAR8;
    LDA8(At, 1, 1); STAGE8(SA8(1, 0), A, lda, brow, tt + 3);
    BAR8; WAIT_L8(0); MMA8(1, 0, At, B0); BAR8; SCHED8;
    STAGE8(SB8(1, 1), Bt, K, bcol + 128, tt + 3);
    WAIT_V8(6); BAR8; MMA8(1, 1, At, B1); BAR8;
  }
  { LDB8(B0, 0, 0); LDA8(At, 0, 0); STAGE8(SA8(1, 1), A, lda, brow + 128, nt - 1);
    BAR8; WAIT_L8(0); MMA8(0, 0, At, B0); BAR8;
    LDB8(B1, 0, 1); BAR8; WAIT_L8(0); MMA8(0, 1, At, B1); BAR8;
    LDA8(At, 0, 1); WAIT_V8(4); BAR8; WAIT_L8(0); MMA8(1, 0, At, B0); MMA8(1, 1, At, B1); BAR8; }
  { LDB8(B0, 1, 0); LDA8(At, 1, 0); WAIT_V8(2); BAR8; WAIT_L8(0); MMA8(0, 0, At, B0); BAR8;
    LDB8(B1, 1, 1); WAIT_V8(0); BAR8; WAIT_L8(0); MMA8(0, 1, At, B1); BAR8;
    LDA8(At, 1, 1); BAR8; WAIT_L8(0); MMA8(1, 0, At, B0); MMA8(1, 1, At, B1); BAR8; }
  if (wr == 0) BAR8;
  __syncthreads();
  if (EPI == EPI_GU && nm0 >= 0) {
    const int t = tid_opaque();
    STAGE8(SB8(0, 0), Bt, K, nn0, 0); STAGE8(SA8(0, 0), A, lda, nm0, 0);
    STAGE8(SB8(0, 1), Bt, K, nn0 + 128, 0); STAGE8(SA8(0, 1), A, lda, nm0 + 128, 0);
  }
#undef SA8
#undef SB8
#undef STAGE8
#undef LDA8
#undef LDB8
#undef MF8
#undef MMA8
#undef WAIT_V8
#undef WAIT_L8
#undef BAR8
#undef SCHED8
  if (t < 256) {
    float rs = 1.f;
    if (e.ss) {
      const float* sp = e.ss + (size_t)(m0 + t) * e.nss;
      float s = 0.f;
      for (int i = 0; i < e.nss; ++i) s += sp[i];
      rs = rsqrtf(s * e.inv_n + EPS);
    }
    ((float*)(smem + SMEM_RSTD))[t] = rs;
  }
  if constexpr (EPI == EPI_GU) {
    __syncthreads();
    const float* rstdL = (const float*)(smem + SMEM_RSTD);
#pragma unroll
    for (int ai = 0; ai < 2; ++ai)
#pragma unroll
      for (int m = 0; m < 4; ++m) {
        const int rowb = ai * 128 + wr * 64 + m * 16 + fq * 4;
        const f32x4 rs4 = *(const f32x4*)(rstdL + rowb);
#pragma unroll
        for (int bj = 0; bj < 2; ++bj) {
          bf16_t* op = e.out + (size_t)(m0 + rowb) * e.ldo + ((n0 + bj * 128 + wc * 32) >> 1) + fr;
#pragma unroll
          for (int j = 0; j < 4; ++j) {
            const float g = acc[ai][bj][m][0][j] * rs4[j], u = acc[ai][bj][m][1][j] * rs4[j];
            const float rv = g * __builtin_amdgcn_rcpf(1.f + fexp2(-g * LOG2E)) * u;
            op[(size_t)j * e.ldo] = (bf16_t)(pack2(rv, 0.f) & 0xffffu);
          }
        }
      }
    __syncthreads();
    return;
  }
  float* T = (float*)smem;
#pragma unroll
  for (int bj = 0; bj < 2; ++bj) {
#pragma unroll
    for (int ai = 0; ai < 2; ++ai)
#pragma unroll
      for (int m = 0; m < 4; ++m)
#pragma unroll
        for (int n = 0; n < 2; ++n)
#pragma unroll
          for (int j = 0; j < 4; ++j)
            T[(ai * 128 + wr * 64 + m * 16 + fq * 4 + j) * 132 + wc * 32 + n * 16 + fr] = acc[ai][bj][m][n][j];
    __syncthreads();
    gemm_epilogue<EPI>(e, m0, n0 + bj * 128);
    __syncthreads();
  }
}

template <int EPI, int BN, bool F16>
DI void gemm_tile(const bf16_t* __restrict__ A, int lda, const bf16_t* __restrict__ W, int K, int m0, int n0, const Ep& e) {
  if constexpr (BN == 256) { gemm_tile256<EPI, F16>(A, lda, W, K, m0, n0, e); return; }
  constexpr int MI = (BN == 256) ? 4 : 2;
  constexpr int NPB = BN / 64;
  const int t = tid_opaque(), l = t & 63, w = t >> 6, r = l & 31, h = l >> 5;
  const int wm = (BN == 256) ? (w >> 2) : (w >> 1), wn = (BN == 256) ? (w & 3) : (w & 1);
  f32x16 acc[MI][2];
#pragma unroll
  for (int i = 0; i < MI; ++i)
#pragma unroll
    for (int j = 0; j < 2; ++j)
#pragma unroll
      for (int k = 0; k < 16; ++k) acc[i][j][k] = 0.f;

  const int grow = w * 8 + (l >> 3);
  const int gch = (l & 7) ^ ((grow >> 1) & 7);
  const bf16_t* ap = A + (size_t)(m0 + grow) * lda + gch * 8;
  const bf16_t* wp = W + (size_t)(n0 + grow) * K + gch * 8;
  unsigned char* lbase = smem + w * 1024;
  const int sw = (r >> 1) & 7;
  const unsigned char* ab = smem + (wm * (MI * 32) + r) * 128;
  const unsigned char* bb = smem + 32768 + (wn * 64 + r) * 128;
  const int nk = K >> 6;
#define G_STAGE(BUF, KT)                                                                              \
  _Pragma("unroll") for (int i = 0; i < 4; ++i) {                                                     \
    __builtin_amdgcn_global_load_lds((const unsigned*)(ap + (size_t)(64 * i) * lda + (KT) * 64),      \
                                     (unsigned*)(lbase + (BUF) * 65536 + i * 8192), 16, 0, 0);        \
    if (i < NPB)                                                                                      \
    __builtin_amdgcn_global_load_lds((const unsigned*)(wp + (size_t)(64 * i) * K + (KT) * 64),        \
                                     (unsigned*)(lbase + (BUF) * 65536 + 32768 + i * 8192), 16, 0, 0);\
  }
#define G_READ(FA, FB, BUF, KS)                                                   \
  {                                                                               \
    const int co = ((2 * (KS) + h) ^ sw) << 4;                                    \
    _Pragma("unroll") for (int mi = 0; mi < MI; ++mi)                             \
      FA[mi] = *(const bf16x8*)(ab + (BUF) * 65536 + mi * 32 * 128 + co);         \
    _Pragma("unroll") for (int ni = 0; ni < 2; ++ni)                              \
      FB[ni] = *(const bf16x8*)(bb + (BUF) * 65536 + ni * 32 * 128 + co);         \
  }
#define G_MMA(FA, FB)                                                             \
  _Pragma("unroll") for (int mi = 0; mi < MI; ++mi)                               \
    _Pragma("unroll") for (int ni = 0; ni < 2; ++ni)                              \
      acc[mi][ni] = F16 ? __builtin_amdgcn_mfma_f32_32x32x16_f16(__builtin_bit_cast(h8_t, FA[mi]), __builtin_bit_cast(h8_t, FB[ni]), acc[mi][ni], 0, 0, 0) \
                        : MFMA32(FA[mi], FB[ni], acc[mi][ni]);
#define G_INTERLEAVE()                                                            \
  _Pragma("unroll") for (int q = 0; q < MI + 2; ++q) {                            \
    __builtin_amdgcn_sched_group_barrier(0x008, 1, 0);                            \
    __builtin_amdgcn_sched_group_barrier(0x100, 1, 0);                            \
  }                                                                               \
  if (MI > 2) __builtin_amdgcn_sched_group_barrier(0x008, MI - 2, 0);
#define G_COMPUTE(BUF)                                                            \
  {                                                                               \
    bf16x8 fa0[MI], fb0[2], fa1[MI], fb1[2];                                      \
    G_READ(fa0, fb0, BUF, 0)                                                      \
    G_READ(fa1, fb1, BUF, 1)                                                      \
    G_MMA(fa0, fb0)                                                               \
    G_INTERLEAVE()                                                                \
    G_READ(fa0, fb0, BUF, 2)                                                      \
    G_MMA(fa1, fb1)                                                               \
    G_INTERLEAVE()                                                                \
    G_READ(fa1, fb1, BUF, 3)                                                      \
    G_MMA(fa0, fb0)                                                               \
    G_INTERLEAVE()                                                                \
    G_MMA(fa1, fb1)                                                               \
  }
#define WAIT_V0() asm volatile("s_waitcnt vmcnt(0)" ::: "memory")
  G_STAGE(0, 0)
  WAIT_V0();
  __syncthreads();
  for (int kt = 0; kt < nk; kt += 2) {
    G_STAGE(1, kt + 1)
    G_COMPUTE(0)
    WAIT_V0();
    __syncthreads();
    if (kt + 2 < nk) { G_STAGE(0, kt + 2) }
    G_COMPUTE(1)
    WAIT_V0();
    __syncthreads();
  }
#undef G_STAGE
#undef G_COMPUTE
#undef G_READ
#undef G_MMA
#undef G_INTERLEAVE
#undef WAIT_V0
  if (t < 256) {
    float rs = 1.f;
    if (e.ss) {
      const float* sp = e.ss + (size_t)(m0 + t) * e.nss;
      float s = 0.f;
      for (int i = 0; i < e.nss; ++i) s += sp[i];
      rs = rsqrtf(s * e.inv_n + EPS);
    }
    ((float*)(smem + SMEM_RSTD))[t] = rs;
  }
  float* T = (float*)smem;
#pragma unroll
  for (int bj = 0; bj < BN / 128; ++bj) {
    if (BN == 128 || (wn >> 1) == bj) {
      const int cb = (BN == 128) ? wn * 64 : (wn & 1) * 64;
#pragma unroll
      for (int mi = 0; mi < MI; ++mi)
#pragma unroll
        for (int ni = 0; ni < 2; ++ni)
#pragma unroll
          for (int i = 0; i < 16; ++i)
            T[(wm * (MI * 32) + mi * 32 + crow(i, h)) * 132 + cb + ni * 32 + r] = acc[mi][ni][i];
    }
    __syncthreads();
    gemm_epilogue<EPI>(e, m0, n0 + bj * 128);
    __syncthreads();
  }
}

struct AttArgs {
  const bf16_t* q; int ldq;
  const bf16_t* k; int ldk;
  const bf16_t* k2; int ldk2;
  const bf16_t* v; int ldv;
  bf16_t* o; int ldo;
  float scale;
  float sink;
  const float* sinkp;
  const float* rpb;
};

template <int DK, int DV, int MODE>
DI void att_gload(const AttArgs& a, int tile, u32x4 (&kr)[(64 * (DK / 8) + NT - 1) / NT], u32x4 (&vr)[(64 * (DV / 8) + NT - 1) / NT]) {
  constexpr int CK = DK / 8, CV = DV / 8;
  constexpr int NKL = (64 * CK + NT - 1) / NT, NVL = (64 * CV + NT - 1) / NT;
  const int t = tid_opaque();
  const int kbase = tile * 64;
#pragma unroll
  for (int i = 0; i < NKL; ++i) {
    const int id = min(t + NT * i, 64 * CK - 1);
    const int row = id / CK, c = id % CK;
    if constexpr (MODE == 3) {
      const bf16_t* src = (c < 8) ? (a.k + (size_t)(kbase + row) * a.ldk + c * 8) : (a.k2 + (size_t)(kbase + row) * a.ldk2 + (c - 8) * 8);
      kr[i] = *(const u32x4*)src;
    } else {
      kr[i] = *(const u32x4*)(a.k + (size_t)(kbase + row) * a.ldk + c * 8);
    }
  }
#pragma unroll
  for (int i = 0; i < NVL; ++i) {
    const int id = t + NT * i;
    const int row = id / CV, c = id % CV;
    vr[i] = *(const u32x4*)(a.v + (size_t)(kbase + row) * a.ldv + c * 8);
  }
}
template <int DK, int DV>
DI void att_swrite(int buf, const u32x4 (&kr)[(64 * (DK / 8) + NT - 1) / NT], const u32x4 (&vr)[(64 * (DV / 8) + NT - 1) / NT]) {
  constexpr int CK = DK / 8, CV = DV / 8;
  constexpr int KST = DK * 2 + 16, VST = DV * 2 + 16;
  constexpr int KBYTES = 64 * KST, VBYTES = 64 * VST, BUFB = KBYTES + VBYTES;
  constexpr int NKL = (64 * CK + NT - 1) / NT, NVL = (64 * CV + NT - 1) / NT;
  const int t = tid_opaque();
#pragma unroll
  for (int i = 0; i < NKL; ++i) {
    const int id = t + NT * i;
    const int row = id / CK, c = id % CK;
    if (id < 64 * CK) *(u32x4*)(smem + buf * BUFB + row * KST + c * 16) = kr[i];
  }
#pragma unroll
  for (int i = 0; i < NVL; ++i) {
    const int id = t + NT * i;
    const int row = id / CV, c = id % CV;
    *(u32x4*)(smem + buf * BUFB + KBYTES + row * VST + c * 16) = vr[i];
  }
}

template <int DK, int DV, int MODE, int QB, bool PACK = false>
DI void attn_item(const AttArgs& a, int q0, int t_lo, int t_hi) {
  constexpr int CK = DK / 8, CV = DV / 8;
  constexpr int KST = DK * 2 + 16, VST = DV * 2 + 16;
  constexpr int KBYTES = 64 * KST, VBYTES = 64 * VST, BUFB = KBYTES + VBYTES;
  constexpr int NKL = (64 * CK + NT - 1) / NT, NVL = (64 * CV + NT - 1) / NT;
  constexpr int NKS = DK / 16, NDB = DV / 32;
  static_assert(2 * BUFB + 2048 <= SMEM_MAIN, "lds");
  static_assert((64 * CV) % NT == 0, "v chunks");
  const int t = tid_opaque(), l = t & 63, w = t >> 6, r = l & 31, h = l >> 5;
  float* rpbs = (float*)(smem + 2 * BUFB);
  const int hg = PACK ? (w >> 1) : 0;
  const int wq0 = PACK ? q0 + (w & 1) * (32 * QB) : q0 + w * (32 * QB);

  int rq = 0, r0 = 0, cq[QB], c0[QB];
#pragma unroll
  for (int qb = 0; qb < QB; ++qb) { cq[qb] = 0; c0[qb] = 0; }
  if constexpr (MODE == 2) {
    rq = wq0 >> 6;
    r0 = min(max(rq - 4, 0), 24);
#pragma unroll
    for (int qb = 0; qb < QB; ++qb) {
      cq[qb] = ((wq0 + qb * 32) & 63) + r;
      c0[qb] = min(max(cq[qb] - 8, 0), 48);
    }
    for (int i = t; i < 465; i += NT) rpbs[i] = a.rpb[i];
  }

  bf16x8 qf[QB][NKS];
#pragma unroll
  for (int qb = 0; qb < QB; ++qb) {
    const bf16_t* qp = a.q + hg * DK + (size_t)(wq0 + qb * 32 + r) * a.ldq + h * 8;
#pragma unroll
    for (int s = 0; s < NKS; ++s) qf[qb][s] = *(const bf16x8*)(qp + s * 16);
  }
  f32x16 o[QB][NDB];
  float m[QB], lsum[QB];
#pragma unroll
  for (int qb = 0; qb < QB; ++qb) {
    m[qb] = -1e30f; lsum[qb] = 0.f;
#pragma unroll
    for (int d = 0; d < NDB; ++d)
#pragma unroll
      for (int i = 0; i < 16; ++i) o[qb][d][i] = 0.f;
  }

  u32x4 kr[NKL], vr[NVL];
  att_gload<DK, DV, MODE>(a, t_lo, kr, vr);
  att_swrite<DK, DV>(0, kr, vr);
  if (t_lo + 1 < t_hi) att_gload<DK, DV, MODE>(a, t_lo + 1, kr, vr);
  __syncthreads();
  const float scale = a.scale;
  const float cexp = (MODE == 2) ? LOG2E : a.scale * LOG2E;
  const int vq = (l & 15) >> 2, vp = l & 3, vblk = (l >> 4) & 1;
  for (int tile = t_lo; tile < t_hi; ++tile) {
    const int buf = (tile - t_lo) & 1;
    if (tile + 1 < t_hi) att_swrite<DK, DV>(buf ^ 1, kr, vr);
    if (tile + 2 < t_hi) att_gload<DK, DV, MODE>(a, tile + 2, kr, vr);
    const unsigned char* Kb = smem + buf * BUFB;
    const unsigned char* Vb = Kb + KBYTES;
    bool active = true;
    if constexpr (MODE == 2) active = (tile >= r0) && (tile < r0 + 8);
    if constexpr (MODE == 1) active = (tile * 64 + 63 >= wq0 - 128) && (tile * 64 <= wq0 + 32 * QB - 1 + 128);
    if (active) {
      f32x16 s[QB][2];
#pragma unroll
      for (int kb = 0; kb < 2; ++kb) {
#pragma unroll
        for (int qb = 0; qb < QB; ++qb)
#pragma unroll
          for (int i = 0; i < 16; ++i) s[qb][kb][i] = 0.f;
        const unsigned char* kp = Kb + (kb * 32 + r) * KST + h * 16;
#pragma unroll
        for (int st = 0; st < NKS; ++st) {
          const bf16x8 kf = *(const bf16x8*)(kp + st * 32);
#pragma unroll
          for (int qb = 0; qb < QB; ++qb) s[qb][kb] = MFMA32(kf, qf[qb][st], s[qb][kb]);
        }
      }
#pragma unroll
      for (int qb = 0; qb < QB; ++qb) {
        const int qidx = wq0 + qb * 32 + r;
        float mloc = -1e30f;
#pragma unroll
        for (int kb = 0; kb < 2; ++kb)
#pragma unroll
          for (int i = 0; i < 16; ++i) {
            float tt = s[qb][kb][i];
            if constexpr (MODE == 1) {
              const int kidx = tile * 64 + kb * 32 + crow(i, h);
              const int d = kidx - qidx;
              tt = (d <= 128 && d >= -128) ? tt : -1e30f;
              s[qb][kb][i] = tt;
            }
            if constexpr (MODE == 2) {
              const int kc = kb * 32 + crow(i, h);
              const bool ok = (kc >= c0[qb]) && (kc < c0[qb] + 16);
              const int bi = ok ? ((tile - rq + 7) * 31 + kc - cq[qb] + 15) : 0;
              tt = ok ? fmaf(tt, scale, rpbs[bi]) : -1e30f;
              s[qb][kb][i] = tt;
            }
            mloc = fmaxf(mloc, tt);
          }
        mloc = fmaxf(mloc, __shfl_xor(mloc, 32));
        if (__any((mloc - m[qb]) * cexp > 8.f)) {
          const float mnew = fmaxf(m[qb], mloc);
          const float alpha = fexp2((m[qb] - mnew) * cexp);
          m[qb] = mnew;
          lsum[qb] *= alpha;
#pragma unroll
          for (int d = 0; d < NDB; ++d)
#pragma unroll
            for (int i = 0; i < 16; ++i) o[qb][d][i] *= alpha;
        }
        const float mc = -m[qb] * cexp;
        const f32x2 c2 = {cexp, cexp}, mc2 = {mc, mc};
        f32x2 ps2 = {0.f, 0.f};
#pragma unroll
        for (int kb = 0; kb < 2; ++kb)
#pragma unroll
          for (int i = 0; i < 16; i += 2) {
            const f32x2 sv = {s[qb][kb][i], s[qb][kb][i + 1]};
            const f32x2 e2 = sv * c2 + mc2;
            f32x2 pv = {fexp2(e2[0]), fexp2(e2[1])};
            if constexpr (MODE == 1 || MODE == 2) {
              pv[0] = (sv[0] > -1e29f) ? pv[0] : 0.f;
              pv[1] = (sv[1] > -1e29f) ? pv[1] : 0.f;
            }
            s[qb][kb][i] = pv[0];
            s[qb][kb][i + 1] = pv[1];
            ps2 += pv;
          }
        lsum[qb] += ps2[0] + ps2[1];
      }
#pragma unroll
      for (int qb = 0; qb < QB; ++qb)
#pragma unroll
        for (int kb = 0; kb < 2; ++kb)
#pragma unroll
          for (int st = 0; st < 2; ++st) {
            u32x4 pk;
            pk[0] = pack2(s[qb][kb][8 * st + 0], s[qb][kb][8 * st + 1]);
            pk[1] = pack2(s[qb][kb][8 * st + 2], s[qb][kb][8 * st + 3]);
            pk[2] = pack2(s[qb][kb][8 * st + 4], s[qb][kb][8 * st + 5]);
            pk[3] = pack2(s[qb][kb][8 * st + 6], s[qb][kb][8 * st + 7]);
            const bf16x8 pf = __builtin_bit_cast(bf16x8, pk);
            const unsigned char* vrow = Vb + (kb * 32 + 16 * st + 4 * h + vq) * VST + (16 * vblk + 4 * vp) * 2;
#pragma unroll
            for (int d = 0; d < NDB; ++d) {
              s16x4 lo = __builtin_amdgcn_ds_read_tr16_b64_v4i16((s16x4 __attribute__((address_space(3)))*)(vrow + d * 64));
              s16x4 hi = __builtin_amdgcn_ds_read_tr16_b64_v4i16((s16x4 __attribute__((address_space(3)))*)(vrow + 8 * VST + d * 64));
              const bf16x8 vf = __builtin_shufflevector(lo, hi, 0, 1, 2, 3, 4, 5, 6, 7);
              o[qb][d] = MFMA32(vf, pf, o[qb][d]);
            }
          }
    }
    __syncthreads();
  }
#pragma unroll
  for (int qb = 0; qb < QB; ++qb) {
    float lt = lsum[qb] + __shfl_xor(lsum[qb], 32);
    if constexpr (MODE == 1) lt += fexp2(((PACK ? a.sinkp[hg] : a.sink) - m[qb] * scale) * LOG2E);
    const float inv = 1.f / lt;
    bf16_t* op = a.o + hg * DV + (size_t)(wq0 + qb * 32 + r) * a.ldo + 8 * h;
#pragma unroll
    for (int d = 0; d < NDB; ++d)
#pragma unroll
      for (int pr = 0; pr < 2; ++pr) {
        const int ia = 8 * pr, ib = 8 * pr + 4;
        const unsigned ax = pack2(o[qb][d][ia] * inv, o[qb][d][ia + 1] * inv), ay = pack2(o[qb][d][ia + 2] * inv, o[qb][d][ia + 3] * inv);
        const unsigned bx = pack2(o[qb][d][ib] * inv, o[qb][d][ib + 1] * inv), by = pack2(o[qb][d][ib + 2] * inv, o[qb][d][ib + 3] * inv);
        const u32x2 sx = __builtin_amdgcn_permlane32_swap(ax, bx, false, false);
        const u32x2 sy = __builtin_amdgcn_permlane32_swap(ay, by, false, false);
        uint4 st;
        st.x = sx[0]; st.y = sy[0]; st.z = sx[1]; st.w = sy[1];
        *(uint4*)(op + 32 * d + 16 * pr) = st;
      }
  }
}

DI int map_col(int mode, int n) {
  if (mode == 1) return n < 416 ? n : n + 96;
  if (mode == 2) {
    const int up = n >= 2816 ? 1 : 0;
    const int j = n - up * 2816;
    if (j < 2560) return (j >> 4) * 32 + up * 16 + (j & 15);
    const int jj = j - 2560;
    return 5120 + (jj >> 5) * 64 + up * 32 + (jj & 31);
  }
  return n;
}

DI void convert_tile(const float* __restrict__ W, int K, int N, const float* __restrict__ g, bf16_t* __restrict__ Wt, int mode, int kt, int nt, bool f16) {
  const int t = tid_opaque();
  float* tile = (float*)smem;
  {
    const int nl = (t & 31) * 4;
    const int n = nt * 128 + nl;
    const int nc = min(n, N - 4);
    float4 v[4];
#pragma unroll
    for (int i = 0; i < 4; ++i) v[i] = *(const float4*)(W + (size_t)(kt * 64 + (t >> 5) + 16 * i) * N + nc);
#pragma unroll
    for (int i = 0; i < 4; ++i) {
      const int kl = (t >> 5) + 16 * i;
      const float gs = g ? g[kt * 64 + kl] : 1.f;
      tile[kl * 129 + nl + 0] = v[i].x * gs;
      tile[kl * 129 + nl + 1] = v[i].y * gs;
      tile[kl * 129 + nl + 2] = v[i].z * gs;
      tile[kl * 129 + nl + 3] = v[i].w * gs;
    }
  }
  __syncthreads();
  {
    const int nl = t >> 2, kc = (t & 3) * 16;
    const int n = nt * 128 + nl;
    if (n < N) {
      float v[16];
#pragma unroll
      for (int j = 0; j < 16; ++j) v[j] = tile[(kc + j) * 129 + nl];
      bf16_t* dst = Wt + (size_t)map_col(mode, n) * K + kt * 64 + kc;
      uint4 u0, u1;
      if (f16) {
        u0.x = pack2h(v[0], v[1]); u0.y = pack2h(v[2], v[3]); u0.z = pack2h(v[4], v[5]); u0.w = pack2h(v[6], v[7]);
        u1.x = pack2h(v[8], v[9]); u1.y = pack2h(v[10], v[11]); u1.z = pack2h(v[12], v[13]); u1.w = pack2h(v[14], v[15]);
      } else {
        u0.x = pack2(v[0], v[1]); u0.y = pack2(v[2], v[3]); u0.z = pack2(v[4], v[5]); u0.w = pack2(v[6], v[7]);
        u1.x = pack2(v[8], v[9]); u1.y = pack2(v[10], v[11]); u1.z = pack2(v[12], v[13]); u1.w = pack2(v[14], v[15]);
      }
      *(uint4*)dst = u0;
      *(uint4*)(dst + 8) = u1;
    }
  }
  __syncthreads();
}

DI void convert_mat(const float* W, int K, int N, const float* g, bf16_t* Wt, int mode, int& off, int vb, int nb, bool f16 = false) {
  const int ntn = (N + 127) >> 7;
  const int ntiles = (K >> 6) * ntn;
  const int first = (int)((vb + nb - (off % nb)) % nb);
  for (int i = first; i < ntiles; i += nb) convert_tile(W, K, N, g, Wt, mode, i / ntn, i % ntn, f16);
  off += ntiles;
}

DI void convert_layer(int L, int vb, int vnb) {
  bf16_t* wb = (bf16_t*)(wsp() + OFF_W) + (size_t)(L & 1) * WSZ;
  const int j = L >> 1;
  int off = 0;
  if ((L & 1) == 0) {
    convert_mat(inp(3) + (size_t)j * 1024 * 1536, 1024, 1536, inp(2) + L * 1024, wb + W_IN, 0, off, vb, vnb, true);
    convert_mat(inp(7) + (size_t)j * 1024 * 1024, 1024, 1024, nullptr, wb + W_OUT, 0, off, vb, vnb);
  } else {
    convert_mat(inp(8) + (size_t)j * 1024 * 1952, 1024, 1952, inp(2) + L * 1024, wb + W_IN, 1, off, vb, vnb, true);
    convert_mat(inp(11) + (size_t)j * 256 * 768, 256, 768, inp(9) + j * 256, wb + W_UQ, 0, off, vb, vnb);
    convert_mat(inp(12) + (size_t)j * 128 * 1024, 128, 1024, inp(10) + j * 128, wb + W_UKV, 0, off, vb, vnb);
    convert_mat(inp(14) + (size_t)j * 1024 * 1024, 1024, 1024, nullptr, wb + W_OUT, 0, off, vb, vnb);
    unsigned zz = 0u;
    asm volatile("" : "+v"(zz));
    uint4 z4 = {zz, zz, zz, zz};
    uint4* zp = (uint4*)(wb + W_IN + (size_t)416 * 1024);
    for (int i = vb * NT + tid_opaque(); i < 96 * 1024 / 8; i += vnb * NT) zp[i] = z4;
  }
  convert_mat(inp(17) + (size_t)L * 1024 * 512, 1024, 512, inp(15) + L * 1024, wb + W_XQ, 0, off, vb, vnb, true);
  convert_mat(inp(18) + (size_t)L * 1024 * 1024, 1024, 1024, inp(16) + L * 1024, wb + W_XKV, 0, off, vb, vnb);
  convert_mat(inp(19) + (size_t)L * 512 * 1024, 512, 1024, nullptr, wb + W_XO, 0, off, vb, vnb);
  convert_mat(inp(21) + (size_t)L * 1024 * 5632, 1024, 5632, inp(20) + L * 1024, wb + W_GU, 2, off, vb, vnb, true);
  convert_mat(inp(22) + (size_t)L * 2816 * 1024, 2816, 1024, nullptr, wb + W_DOWN, 0, off, vb, vnb);
}

DI void row_prep(const float* __restrict__ src, float* __restrict__ dstf, bf16_t* __restrict__ dstb, float* __restrict__ ssq, int nslots, int nrows, bool f16) {
  const int t = tid_opaque(), l = t & 63, w = t >> 6;
  for (int row = blockIdx.x * 8 + w; row < nrows; row += gridDim.x * 8) {
    const float4* sp = (const float4*)(src + (size_t)row * DM);
    float s2 = 0.f;
#pragma unroll
    for (int i = 0; i < 4; ++i) {
      float4 v = sp[l + 64 * i];
      s2 += v.x * v.x + v.y * v.y + v.z * v.z + v.w * v.w;
      if (dstf) ((float4*)(dstf + (size_t)row * DM))[l + 64 * i] = v;
      uint2 u;
      if (f16) { u.x = pack2h(v.x, v.y); u.y = pack2h(v.z, v.w); } else { u.x = pack2(v.x, v.y); u.y = pack2(v.z, v.w); }
      ((uint2*)(dstb + (size_t)row * DM))[l + 64 * i] = u;
    }
#pragma unroll
    for (int o = 32; o; o >>= 1) s2 += __shfl_xor(s2, o);
    if (l < nslots) ssq[(size_t)row * nslots + l] = (l == 0) ? s2 : 0.f;
  }
}

DI double dpow(double c, int n) { double r = 1.0; for (int i = 0; i < n; ++i) r *= c; return r; }
DI float2 cossin(double ang) {
  double rev = ang * 0.15915494309189535;
  rev -= rint(rev);
  const float f = (float)rev;
  float2 o;
  o.x = __builtin_amdgcn_cosf(f);
  o.y = __builtin_amdgcn_sinf(f);
  return o;
}

#define G_WS (wsp())
#define G_XF (outp())
#define G_XB ((bf16_t*)(wsp() + OFF_XB))
#define G_ZB ((bf16_t*)(wsp() + OFF_Z))
#define G_OB ((bf16_t*)(wsp() + OFF_O))
#define G_QC ((bf16_t*)(wsp() + OFF_QC))
#define G_KVC ((bf16_t*)(wsp() + OFF_KVC))
#define G_MEMB ((bf16_t*)(wsp() + OFF_MEMB))
#define G_MEMKV ((bf16_t*)(wsp() + OFF_MEMKV))
#define G_XQ ((bf16_t*)(wsp() + OFF_Z))
#define G_XO ((bf16_t*)(wsp() + OFF_Z) + (size_t)NTOK * 512)
#define G_ACT ((bf16_t*)(wsp() + OFF_Z))
#define G_SS ((float*)(wsp() + OFF_SS))
#define G_SSMEM ((float*)(wsp() + OFF_SSMEM))
#define G_SSCQ ((float*)(wsp() + OFF_SSCQ))
#define G_SSCKV ((float*)(wsp() + OFF_SSCKV))
#define G_CS1 ((float2*)(wsp() + OFF_CS1))
#define G_CS2 ((float2*)(wsp() + OFF_CS2))
#define G_CSC ((float2*)(wsp() + OFF_CSC))
__global__ void __launch_bounds__(512, 2) mega(Params p) {
  cg::grid_group grid = cg::this_grid();
  const int nb = gridDim.x, bid = blockIdx.x, t = threadIdx.x;
  if (wsp() == nullptr) grid.sync();
  volatile LAS unsigned* xst = (volatile LAS unsigned*)(smem + SMEM_MAIN);
  if (t < 4) xst[t] = 0u;
  __syncthreads();
  const XcdBarrier xbar = xcd_barrier_post((unsigned*)(G_WS + OFF_BAR), xst);
  row_prep(inp(0), nullptr, G_XB, G_SS, 16, NTOK, true);
  row_prep(inp(1), nullptr, G_MEMB, G_SSMEM, 1, 2048, false);
  for (int idx = bid * NT + tid_opaque(); idx < 163840; idx += nb * NT) {
    if (idx < 65536) {
      const int pos = idx >> 5, i = idx & 31;
      G_CS1[idx] = cossin((double)pos * dpow(0.7498942093324559, i));
    } else if (idx < 131072) {
      const int e = idx - 65536;
      const int pos = e >> 5, i = e & 31;
      const double a = (i < 16) ? (double)(pos >> 6) * dpow(0.5623413251903491, i) : (double)(pos & 63) * dpow(0.5623413251903491, i - 16);
      G_CS2[e] = cossin(a);
    } else {
      const int e = idx - 131072;
      const int pos = e >> 4, i = e & 15;
      G_CSC[e] = cossin((double)pos * dpow(0.5623413251903491, i));
    }
  }
  convert_layer(0, bid, nb);
  GSYNC();

  for (int L = 0; L < 4; ++L) {
    const int j = L >> 1;
    const bool odd = (L & 1) != 0;
    const bf16_t* wb = (const bf16_t*)(G_WS + OFF_W) + (size_t)(L & 1) * WSZ;
    Ep e{};
    e.cs1 = G_CS1; e.cs2 = G_CS2; e.csc = G_CSC;

    {
      const int nin = (odd ? 8 : 6) * 64;
      for (int rp = 0; rp < REP_P1; ++rp)
      for (int item = bid; item < nin; item += nb) {
        const int nt = item >> 6, mt = item & 63;
        e.ss = G_SS; e.nss = 16; e.inv_n = 1.f / 1024.f; e.out = G_ZB; e.ldo = ZLD;
        if (!odd) {
          e.g_a = inp(4) + j * 64; e.g_b = inp(5) + j * 64;
          gemm_tile<EPI_IN_AB, 256, true>(G_XB, DM, wb + W_IN, DM, mt * 256, nt * 256, e);
        } else {
          e.ss_cq = G_SSCQ; e.ss_ckv = G_SSCKV;
          gemm_tile<EPI_IN_CD, 256, true>(G_XB, DM, wb + W_IN, DM, mt * 256, nt * 256, e);
        }
      }
      const bool memkv_in_p1 = !odd && nb == 256;
      if (memkv_in_p1) {
        if (bid >= 224) {
          const int it = bid - 224;
          const int nt = it >> 3, mt = it & 7;
          e.ss = G_SSMEM; e.nss = 1; e.inv_n = 1.f / 1024.f; e.out = G_MEMKV; e.ldo = 1024;
          gemm_tile<EPI_PLAIN, 256, false>(G_MEMB, DM, wb + W_XKV, DM, mt * 256, nt * 256, e);
        } else if (bid >= 128 && L < 3) convert_layer(L + 1, bid - 128, 96);
      } else if (L < 3) { if (odd || nb < 256) convert_layer(L + 1, bid, nb); else if (bid >= 128) convert_layer(L + 1, bid - 128, nb - 128); }
    }
    GSYNC();
    if (odd) {
      const int total = 3 * 64 + 8 * 64;
      for (int rp = 0; rp < REP_P1; ++rp)
      for (int item = bid; item < total; item += nb) {
        if (item < 192) {
          const int nt = item >> 6, mt = item & 63;
          e.ss = G_SSCQ; e.nss = 4; e.inv_n = 1.f / 256.f; e.out = G_QC; e.ldo = 768;
          gemm_tile<EPI_UQ, 256, false>(G_ZB, ZLD, wb + W_UQ, 256, mt * 256, nt * 256, e);
        } else {
          const int it = item - 192;
          const int nt = it >> 6, mt = it & 63;
          e.ss = G_SSCKV; e.nss = 2; e.inv_n = 1.f / 128.f; e.out = G_KVC; e.ldo = 1024;
          gemm_tile<EPI_PLAIN, 128, false>(G_ZB + 256, ZLD, wb + W_UKV, 128, mt * 256, nt * 128, e);
        }
      }
      GSYNC();
    }
    for (int rp = 0; rp < REP_P2; ++rp)
    for (int item = bid; item < 512; item += nb) {
      const int idx = item & 255;
      const int pl = idx & 7, rest = idx >> 3;
      AttArgs a{};
      int Lp2 = L; asm volatile("" : "+s"(Lp2));
      if (!(Lp2 & 1)) {
        const int qg = rest & 15, pg = rest >> 4;
        const int pair = pg * 8 + pl;
        const int b = pair >> 1, kvh = pair & 1;
        const int qt = qg >> 2, g = qg & 3;
        const int head = kvh * 4 + g;
        const bf16_t* zrow = G_ZB + (size_t)b * SEQ * ZLD;
        a.ldq = a.ldk = a.ldv = ZLD; a.ldo = DM;
        a.scale = 0.125f;
        const int q0 = qt * 512;
        if (item < 256) {
          a.q = zrow + head * 64; a.k = zrow + 512 + kvh * 64; a.v = zrow + 640 + kvh * 64;
          a.o = G_OB + (size_t)b * SEQ * DM + head * 64;
          attn_item<64, 64, 0, 2>(a, q0, 0, 32);
        } else {
          const int qtb = rest & 15, pgb = rest >> 4;
          const int pairb = pgb * 8 + pl;
          const int bb = pairb >> 1, kvb = pairb & 1;
          const bf16_t* zrb = G_ZB + (size_t)bb * SEQ * ZLD;
          a.q = zrb + 768 + kvb * 256; a.k = zrb + 1280 + kvb * 64; a.v = zrb + 1408 + kvb * 64;
          a.o = G_OB + (size_t)bb * SEQ * DM + 512 + kvb * 256;
          a.sinkp = inp(6) + j * 8 + kvb * 4;
          const int q0b = qtb * 128;
          const int tlo = max(q0b - 128, 0) >> 6, thi = min(q0b + 128 + 128, SEQ) >> 6;
          attn_item<64, 64, 1, 2, true>(a, q0b, tlo, thi);
        }
      } else {
        const int qt = rest & 3, pg = rest >> 2;
        const int pair = pg * 8 + pl;
        const int b = pair >> 3, hd = pair & 7;
        const int q0 = qt * 512;
        const bf16_t* zrow = G_ZB + (size_t)b * SEQ * ZLD;
        if (item < 256) {
          a.q = G_QC + (size_t)b * SEQ * 768 + hd * 96; a.ldq = 768;
          a.k = G_KVC + (size_t)b * SEQ * 1024 + hd * 128; a.ldk = 1024;
          a.k2 = zrow + 384; a.ldk2 = ZLD;
          a.v = G_KVC + (size_t)b * SEQ * 1024 + hd * 128 + 64; a.ldv = 1024;
          a.o = G_OB + (size_t)b * SEQ * DM + hd * 64; a.ldo = DM;
          a.scale = 0.10206207261596577f;
          attn_item<96, 64, 3, 2>(a, q0, 0, 32);
        } else {
          a.q = zrow + 512 + hd * 64; a.k = zrow + 1024 + hd * 64; a.v = zrow + 1536 + hd * 64;
          a.ldq = a.ldk = a.ldv = ZLD;
          a.o = G_OB + (size_t)b * SEQ * DM + 512 + hd * 64; a.ldo = DM;
          a.scale = 0.125f;
          a.rpb = inp(13) + (size_t)(j * 8 + hd) * 465;
          const int ra = q0 >> 6;
          const int tlo = min(max(ra - 4, 0), 24), thi = min(max(ra + 7 - 4, 0), 24) + 8;
          attn_item<64, 64, 2, 2>(a, q0, tlo, thi);
        }
      }
    }
    GSYNC();
    for (int item = bid; item < 4 * 64; item += nb) {
      const int nt = item >> 6, mt = item & 63;
      e.ss = nullptr; e.xf = G_XF; e.xb = G_XB; e.ss_out = G_SS;
      gemm_tile<EPI_RESID, 256, false>(G_OB, DM, wb + W_OUT, DM, mt * 256, nt * 256, e);
    }
    GSYNC();
    for (int rp = 0; rp < REP_P4; ++rp)
    if (!odd && nb == 256) {
      for (int item = bid; item < 4 * 64; item += nb) {
        const int nt = item >> 6, mt = item & 63;
        e.ss = G_SS; e.nss = 16; e.inv_n = 1.f / 1024.f; e.out = G_XQ; e.ldo = 512;
        gemm_tile<EPI_PLAIN, 128, true>(G_XB, DM, wb + W_XQ, DM, mt * 256, nt * 128, e);
      }
    } else
    for (int item = bid; item < 2 * 64 + 4 * 8; item += nb) {
      if (item < 128) {
        const int nt = item >> 6, mt = item & 63;
        e.ss = G_SS; e.nss = 16; e.inv_n = 1.f / 1024.f; e.out = G_XQ; e.ldo = 512;
        gemm_tile<EPI_PLAIN, 256, true>(G_XB, DM, wb + W_XQ, DM, mt * 256, nt * 256, e);
      } else {
        const int it = item - 128;
        const int nt = it >> 3, mt = it & 7;
        e.ss = G_SSMEM; e.nss = 1; e.inv_n = 1.f / 1024.f; e.out = G_MEMKV; e.ldo = 1024;
        gemm_tile<EPI_PLAIN, 256, false>(G_MEMB, DM, wb + W_XKV, DM, mt * 256, nt * 256, e);
      }
    }
    GSYNC();
    for (int rp = 0; rp < REP_P4; ++rp)
    for (int item = bid; item < 256; item += nb) {
      const int pl = item & 7, rest = item >> 3;
      const int qt = rest & 7, pg = rest >> 3;
      const int pair = pg * 8 + pl;
      const int b = pair >> 2, hd = pair & 3;
      AttArgs a{};
      a.q = G_XQ + (size_t)b * SEQ * 512 + hd * 128; a.ldq = 512;
      a.k = G_MEMKV + (size_t)b * 256 * 1024 + hd * 128; a.ldk = 1024;
      a.v = G_MEMKV + (size_t)b * 256 * 1024 + 512 + hd * 128; a.ldv = 1024;
      a.o = G_XO + (size_t)b * SEQ * 512 + hd * 128; a.ldo = 512;
      a.scale = 0.08838834764831845f;
      attn_item<128, 128, 0, 1>(a, qt * 256, 0, 4);
    }
    GSYNC();
    for (int item = bid; item < 4 * 64; item += nb) {
      const int nt = item >> 6, mt = item & 63;
      e.ss = nullptr; e.xf = G_XF; e.xb = G_XB; e.ss_out = G_SS;
      gemm_tile<EPI_RESID, 256, false>(G_XO, 512, wb + W_XO, 512, mt * 256, nt * 256, e);
    }
    GSYNC();
    bool pre7 = false;
    for (int rp = 0; rp < REP_P7; ++rp)
    for (int item = bid; item < 20 * 64 + 4 * 64; item += nb) {
      e.ss = G_SS; e.nss = 16; e.inv_n = 1.f / 1024.f; e.out = G_ACT; e.ldo = 2816;
      if (item < 1280) {
        const int nt = item >> 6, mt = item & 63;
        const int nxt = item + nb;
        const bool chain = nxt < 1280;
        gemm_tile256<EPI_GU, true>(G_XB, DM, wb + W_GU, DM, mt * 256, nt * 256, e, pre7, chain ? (nxt & 63) * 256 : -1, (nxt >> 6) * 256);
        pre7 = chain;
      } else {
        const int it = item - 1280;
        const int nt = it >> 6, mt = it & 63;
        gemm_tile<EPI_GU, 128, true>(G_XB, DM, wb + W_GU, DM, mt * 256, 5120 + nt * 128, e);
      }
    }
    GSYNC();
    for (int item = bid; item < 4 * 64; item += nb) {
      const int nt = item >> 6, mt = item & 63;
      e.ss = nullptr; e.xf = G_XF; e.xb = G_XB; e.ss_out = G_SS;
      gemm_tile<EPI_RESID, 256, false>(G_ACT, 2816, wb + W_DOWN, 2816, mt * 256, nt * 256, e);
    }
    GSYNC();
  }
  {
    const int t2 = tid_opaque();
    const int w = t2 >> 6, l = t2 & 63;
    const float4* gf = (const float4*)inp(23);
    for (int row = bid * 8 + w; row < NTOK; row += nb * 8) {
      const uint2* xp = (const uint2*)(G_XB + (size_t)row * DM);
      float4* op = (float4*)(G_XF + (size_t)row * DM);
      float4 v[4];
      float s2 = 0.f;
#pragma unroll
      for (int i = 0; i < 4; ++i) {
        const uint2 u = xp[l + 64 * i];
        v[i].x = h_lo(u.x); v[i].y = h_hi(u.x);
        v[i].z = h_lo(u.y); v[i].w = h_hi(u.y);
        s2 += v[i].x * v[i].x + v[i].y * v[i].y + v[i].z * v[i].z + v[i].w * v[i].w;
      }
#pragma unroll
      for (int o = 32; o; o >>= 1) s2 += __shfl_xor(s2, o);
      const float rr = rsqrtf(s2 * (1.f / 1024.f) + EPS);
#pragma unroll
      for (int i = 0; i < 4; ++i) {
        const float4 g = gf[l + 64 * i];
        float4 o4 = {v[i].x * rr * g.x, v[i].y * rr * g.y, v[i].z * rr * g.z, v[i].w * rr * g.w};
        op[l + 64 * i] = o4;
      }
    }
  }
}
#undef G_WS
#undef G_XF
#undef G_XB
#undef G_ZB
#undef G_OB
#undef G_QC
#undef G_KVC
#undef G_MEMB
#undef G_MEMKV
#undef G_XQ
#undef G_XO
#undef G_ACT
#undef G_SS
#undef G_SSMEM
#undef G_SSCQ
#undef G_SSCKV
#undef G_CS1
#undef G_CS2
#undef G_CSC
extern "C" void kernel_launch(void* const* d_in, const int* in_sizes, int n_in, void* d_out, int out_size, void* d_ws, size_t ws_size, hipStream_t stream) {
  static int grid_blocks = 0;
  if (!grid_blocks) {
    int dev = 0, cus = 0, per_cu = 0;
    hipGetDevice(&dev);
    hipDeviceGetAttribute(&cus, hipDeviceAttributeMultiprocessorCount, dev);
    hipOccupancyMaxActiveBlocksPerMultiprocessor(&per_cu, mega, NT, 0);
    if (per_cu > 1) per_cu = 1;
    if (per_cu < 1) per_cu = 1;
    grid_blocks = cus * per_cu;
  }
  Params p{};
  for (int i = 0; i < 24; ++i) p.in[i] = (const float*)d_in[i];
  p.out = (float*)d_out;
  p.ws = (unsigned char*)d_ws;
  void* args[] = {&p};
  hipMemsetAsync((unsigned char*)d_ws + OFF_BAR, 0, XCD_BAR_WORDS * sizeof(unsigned), stream);
  hipError_t e = hipLaunchCooperativeKernel((void*)mega, dim3(grid_blocks), dim3(NT), args, 0, stream);
  if (e != hipSuccess) fprintf(stderr, "cooperative launch failed: %s (grid %d)\n", hipGetErrorString(e), grid_blocks);
}
```
